# Optimizing an MI355X kernel written in HIP

```python
import jax, jax.numpy as jnp
from jax import lax
import numpy as np

D_MODEL = 1024
BATCH = 2
SEQ = 16384
DEPTH = 4

HEAD_DIM = 64
N_ATTN_HEADS = 8
N_IDX_HEADS = 4
IDX_DIM = 64
TOPK_MAX = 256
POOL_WINDOWS = (2, 4, 8, 16)
N_POOL_GROUPS = 4
POOL_GROUP_DIM = 64
N_MEM_HEADS = 4
N_MEM = 256
D_FF = 2816
Q_BLOCK = 128
EPS = 1e-6

ATTN_W = N_ATTN_HEADS * HEAD_DIM
POOL_W = N_POOL_GROUPS * POOL_GROUP_DIM
MEM_W = N_MEM_HEADS * HEAD_DIM
D_MIX = ATTN_W + POOL_W + MEM_W
IN_SIZES = (ATTN_W, ATTN_W, ATTN_W, N_IDX_HEADS * IDX_DIM, IDX_DIM, N_IDX_HEADS, POOL_W, MEM_W)
IN_OFFSETS = tuple(sum(IN_SIZES[:i + 1]) for i in range(len(IN_SIZES) - 1))
D_IN = sum(IN_SIZES)

kernel_name = "hybrid_dsa_pool_memory_macaron"


def rms_norm(x, g):
    xf = x.astype(jnp.float32)
    y = xf * lax.rsqrt(jnp.mean(xf * xf, axis=-1, keepdims=True) + EPS)
    return (y * g.astype(jnp.float32)).astype(x.dtype)


def swiglu(h, w_gate, w_up, w_down):
    return (jax.nn.silu(h @ w_gate) * (h @ w_up)) @ w_down


def dsa_attention(q, k, v, iq, ik, iw):
    B, S = q.shape[0], q.shape[1]
    n_sel = min(TOPK_MAX, S // 4)
    nb = S // Q_BLOCK
    pos = jnp.arange(S, dtype=jnp.int32)

    def to_blocks(a):
        return jnp.moveaxis(a.reshape((B, nb, Q_BLOCK) + a.shape[2:]), 1, 0)

    def block(args):
        qb, iqb, iwb, tb = args
        dots = jnp.einsum('bqhd,bsd->bqhs', iqb, ik).astype(jnp.float32) * (IDX_DIM ** -0.5)
        score = jnp.einsum('bqhs,bqh->bqs', jax.nn.relu(dots),
                           iwb.astype(jnp.float32) * (N_IDX_HEADS ** -0.5))
        score = jnp.where(pos[None, None, :] <= tb[None, :, None], score, -jnp.inf)
        _, idx = lax.top_k(score, n_sel)
        valid = idx <= tb[None, :, None]
        kg = jax.vmap(lambda kb, ib: kb[ib])(k, idx)
        vg = jax.vmap(lambda vb, ib: vb[ib])(v, idx)
        logits = jnp.einsum('bqhd,bqkhd->bhqk', qb, kg).astype(jnp.float32) * (HEAD_DIM ** -0.5)
        logits = jnp.where(valid[:, None], logits, -jnp.inf)
        p = jax.nn.softmax(logits, axis=-1).astype(vg.dtype)
        return jnp.einsum('bhqk,bqkhd->bqhd', p, vg)

    out = lax.map(block, (to_blocks(q), to_blocks(iq), to_blocks(iw), pos.reshape(nb, Q_BLOCK)))
    return jnp.moveaxis(out, 0, 1).reshape(B, S, -1)


def multiscale_pool(u, w_pool, scale):
    B, S = u.shape[0], u.shape[1]
    uf = u.astype(jnp.float32)
    c = jnp.cumsum(uf, axis=1)
    t1 = jnp.arange(1, S + 1, dtype=jnp.float32)
    means = []
    for g, win in enumerate(POOL_WINDOWS):
        cg = c[:, :, g]
        lagged = jnp.pad(cg, ((0, 0), (win, 0), (0, 0)))[:, :S]
        means.append((cg - lagged) / jnp.minimum(t1, float(win))[None, :, None])
    pooled = (jnp.stack(means, axis=2) - uf).astype(u.dtype)
    y = jnp.einsum('bsgc,gcd->bsgd', pooled, w_pool)
    return y.reshape(B, S, POOL_W) * scale


def memory_attention(mq, mem_n, w_kv, mq_g, mk_g):
    B, M = mem_n.shape[0], mem_n.shape[1]
    mk, mv = jnp.split(mem_n @ w_kv, 2, axis=-1)
    mk = rms_norm(mk.reshape(B, M, N_MEM_HEADS, HEAD_DIM), mk_g)
    mv = mv.reshape(B, M, N_MEM_HEADS, HEAD_DIM)
    mq = rms_norm(mq, mq_g)
    logits = jnp.einsum('bshd,bmhd->bhsm', mq, mk).astype(jnp.float32) * (HEAD_DIM ** -0.5)
    p = jax.nn.softmax(logits, axis=-1).astype(mv.dtype)
    out = jnp.einsum('bhsm,bmhd->bshd', p, mv)
    return out.reshape(out.shape[0], out.shape[1], MEM_W)


def setup_inputs(seed: int = 0) -> dict:
    key = jax.random.key(seed)
    ks = jax.random.split(key, 24)
    f32 = jnp.float32

    def nrm(k, shape, fan_in):
        return jax.random.normal(k, shape, f32) * (fan_in ** -0.5)

    def gain(k, shape):
        return 1.0 + 0.02 * jax.random.normal(k, shape, f32)

    return {
        "x": jax.random.normal(ks[0], (BATCH, SEQ, D_MODEL), f32),
        "mem": jax.random.normal(ks[1], (BATCH, N_MEM, D_MODEL), f32),
        "ffn1_norm": gain(ks[2], (DEPTH, D_MODEL)),
        "ffn1_gate": nrm(ks[3], (DEPTH, D_MODEL, D_FF), D_MODEL),
        "ffn1_up": nrm(ks[4], (DEPTH, D_MODEL, D_FF), D_MODEL),
        "ffn1_down": nrm(ks[5], (DEPTH, D_FF, D_MODEL), D_FF),
        "mix_norm": gain(ks[6], (DEPTH, D_MODEL)),
        "mem_norm": gain(ks[7], (DEPTH, D_MODEL)),
        "w_in": nrm(ks[8], (DEPTH, D_MODEL, D_IN), D_MODEL),
        "q_norm": gain(ks[9], (DEPTH, HEAD_DIM)),
        "k_norm": gain(ks[10], (DEPTH, HEAD_DIM)),
        "w_pool": nrm(ks[11], (DEPTH, N_POOL_GROUPS, POOL_GROUP_DIM, POOL_GROUP_DIM), POOL_GROUP_DIM),
        "pool_scale": gain(ks[12], (DEPTH, POOL_W)),
        "w_mem_kv": nrm(ks[13], (DEPTH, D_MODEL, 2 * MEM_W), D_MODEL),
        "mq_norm": gain(ks[14], (DEPTH, HEAD_DIM)),
        "mk_norm": gain(ks[15], (DEPTH, HEAD_DIM)),
        "w_out": nrm(ks[16], (DEPTH, D_MIX, D_MODEL), D_MIX),
        "ffn2_norm": gain(ks[17], (DEPTH, D_MODEL)),
        "ffn2_gate": nrm(ks[18], (DEPTH, D_MODEL, D_FF), D_MODEL),
        "ffn2_up": nrm(ks[19], (DEPTH, D_MODEL, D_FF), D_MODEL),
        "ffn2_down": nrm(ks[20], (DEPTH, D_FF, D_MODEL), D_FF),
    }


def reference(x, mem, ffn1_norm, ffn1_gate, ffn1_up, ffn1_down, mix_norm, mem_norm, w_in,
              q_norm, k_norm, w_pool, pool_scale, w_mem_kv, mq_norm, mk_norm, w_out,
              ffn2_norm, ffn2_gate, ffn2_up, ffn2_down):
    B, S = x.shape[0], x.shape[1]
    for l in range(DEPTH):
        x = x + 0.5 * swiglu(rms_norm(x, ffn1_norm[l]), ffn1_gate[l], ffn1_up[l], ffn1_down[l])

        h = rms_norm(x, mix_norm[l])
        z = h @ w_in[l]
        aq, ak, av, iq, ik, iw, pu, mq = jnp.split(z, IN_OFFSETS, axis=-1)

        aq = rms_norm(aq.reshape(B, S, N_ATTN_HEADS, HEAD_DIM), q_norm[l])
        ak = rms_norm(ak.reshape(B, S, N_ATTN_HEADS, HEAD_DIM), k_norm[l])
        av = av.reshape(B, S, N_ATTN_HEADS, HEAD_DIM)
        iq = iq.reshape(B, S, N_IDX_HEADS, IDX_DIM)
        y_attn = dsa_attention(aq, ak, av, iq, ik, iw)

        y_pool = multiscale_pool(pu.reshape(B, S, N_POOL_GROUPS, POOL_GROUP_DIM),
                                 w_pool[l], pool_scale[l])

        y_mem = memory_attention(mq.reshape(B, S, N_MEM_HEADS, HEAD_DIM),
                                 rms_norm(mem, mem_norm[l]), w_mem_kv[l],
                                 mq_norm[l], mk_norm[l])

        x = x + jnp.concatenate([y_attn, y_pool, y_mem], axis=-1) @ w_out[l]

        x = x + 0.5 * swiglu(rms_norm(x, ffn2_norm[l]), ffn2_gate[l], ffn2_up[l], ffn2_down[l])
    return x
```

```cpp
#ifndef SITE_MASK
#define SITE_MASK 0xff
#endif
#include <hip/hip_runtime.h>
#include <cstdio>
#include <cstdint>
namespace pg8 {
#define PG8_LAS __attribute__((address_space(3)))
typedef unsigned short bf16_t;
typedef short bf16x8 __attribute__((ext_vector_type(8)));
typedef float f32x4 __attribute__((ext_vector_type(4)));
typedef unsigned u32x4 __attribute__((ext_vector_type(4)));
constexpr int BM = 256, BK = 64, HALF = 128, HTB = HALF * BK * 2  , STAGE_BYTES = 8 * HTB, NXCD = 8, WGM = 8;

__host__ __device__ __forceinline__ int lds_byte(int r, int c) { const int st = (r >> 4) * 2 + (c >> 5), rr = r & 15, cc = c & 31, ob = rr * 64 + cc * 2; return st * 1024 + (ob ^ (((ob >> 9) & 1) << 5)); }
__host__ __device__ __forceinline__ void stage_rc(int b, int& R, int& C) { const int st = b / 1024, sb = b % 1024, swz = sb ^ (((sb >> 9) & 1) << 5); R = (st >> 1) * 16 + swz / 64; C = (st & 1) * 32 + (swz % 64) / 2; }
__host__ __device__ __forceinline__ int perm32(int rho) { const int n = rho >> 4, i = rho & 15; return 8 * (i >> 2) + 4 * n + (i & 3); }

struct Unit { int pm, pn; };
struct Gemm { const bf16_t* A; const bf16_t* Bt; int M, N, K; };

struct StaticOrder {
    int nM, nN, nwg, G, c;
    __host__ __device__ void init(int M, int N, int G_, int c_) { nM = M / BM; nN = N / BM; nwg = nM * nN; G = G_; c = c_; }
    __host__ __device__ bool next(int i, Unit& u) const {
        const long L = (long)i * G + c; if (L >= nwg) return false;
        int wgid = (int)L; { const int q = nwg / NXCD, r = nwg % NXCD, xcd = wgid % NXCD, off = wgid / NXCD; wgid = (xcd < r ? xcd * (q + 1) : r * (q + 1) + (xcd - r) * q) + off; }
        const int nig = WGM * nN, gid = wgid / nig, fm = gid * WGM, gsz = (nM - fm) < WGM ? (nM - fm) : WGM;
        u.pm = fm + ((wgid % nig) % gsz); u.pn = (wgid % nig) / gsz; return true;
    }
    __device__ __forceinline__ void a_ready(const Unit&) const {}
    __device__ __forceinline__ void done(const Unit&) const {}
};
__device__ __forceinline__ unsigned cvt_pk_bf16(float lo, float hi) { unsigned r; asm volatile("v_cvt_pk_bf16_f32 %0, %1, %2" : "=v"(r) : "v"(lo), "v"(hi)); return r; }
template <class Epi, class Sched, bool ALIGN_EPI = false, bool SP2 = false>
__device__ __forceinline__ void gemm_phase(PG8_LAS unsigned char* lds, const Gemm g, const Sched& S, const Epi& E) {
    int tid_ = threadIdx.x; asm volatile("" : "+v"(tid_));
    const int tid = tid_, wid = __builtin_amdgcn_readfirstlane(tid >> 6), lane = tid & 63, wr = wid >> 2, wc = wid & 3, fr = lane & 15, fq = lane >> 4;
    const int K = g.K, nt = K / BK;
    unsigned voffA[2], voffB[2];
#pragma unroll
    for (int i = 0; i < 2; ++i) { int R, C; stage_rc(tid * 16 + i * 8192, R, C); const int Rb = Epi::PERM ? ((R & ~31) + perm32(R & 31)) : R;
        voffA[i] = (unsigned)(R * K + C) * 2u; voffB[i] = (unsigned)(Rb * K + C) * 2u; }
    const size_t kstep = (size_t)(BK * 2);
    const size_t hstep = (size_t)HALF * K * 2;
    const size_t tstep = 2 * hstep;
    const unsigned ldsw = (unsigned)wid * 1024u;
    const int aoff = lds_byte(wr * 64 + fr, fq * 8), boff = lds_byte(wc * 32 + fr, fq * 8);
#define PG8_SA(b, h) (((b) * 2 + (h)) * HTB)
#define PG8_SB(b, h) ((4 + (b) * 2 + (h)) * HTB)
#define PG8_STAGE(bufoff, gbase, voff) do { _Pragma("unroll") for (int _i = 0; _i < 2; ++_i) \
        __builtin_amdgcn_global_load_lds((const unsigned*)((const char*)(gbase) + (voff)[_i]), (PG8_LAS unsigned*)(lds + (bufoff) + ldsw + _i * 8192), 16, 0, 0); } while (0)
#define PG8_LDA(dst, b, h) do { _Pragma("unroll") for (int m = 0; m < 4; ++m) _Pragma("unroll") for (int k = 0; k < 2; ++k) dst[m][k] = *(const PG8_LAS bf16x8*)(lds + PG8_SA(b, h) + aoff + m * 2048 + k * 1024); } while (0)
#define PG8_LDB(dst, b, h) do { _Pragma("unroll") for (int n = 0; n < 2; ++n) _Pragma("unroll") for (int k = 0; k < 2; ++k) dst[n][k] = *(const PG8_LAS bf16x8*)(lds + PG8_SB(b, h) + boff + n * 2048 + k * 1024); } while (0)
#define PG8_MMA(ai, bj, At, Bt) do { __builtin_amdgcn_s_setprio(1); _Pragma("unroll") for (int m = 0; m < 4; ++m) _Pragma("unroll") for (int n = 0; n < 2; ++n) _Pragma("unroll") for (int k = 0; k < 2; ++k) \
        acc[ai][bj][m][n] = __builtin_amdgcn_mfma_f32_16x16x32_bf16(Bt[n][k], At[m][k], acc[ai][bj][m][n], 0, 0, 0); __builtin_amdgcn_s_setprio(0); } while (0)
#define PG8_WAIT_V(n) asm volatile("s_waitcnt vmcnt(" #n ")" ::: "memory")
#define PG8_WAIT_L(n) asm volatile("s_waitcnt lgkmcnt(" #n ")" ::: "memory")
#define PG8_BAR __builtin_amdgcn_s_barrier()
#define PG8_SCHED __builtin_amdgcn_sched_barrier(0)
    Unit cur, nxt; int ui = 0;
    if (!S.next(0, cur)) return;
    f32x4 acc[2][2][4][2];
#pragma unroll
    for (int a = 0; a < 2; ++a)
#pragma unroll
        for (int b = 0; b < 2; ++b)
#pragma unroll
            for (int m = 0; m < 4; ++m)
#pragma unroll
                for (int n = 0; n < 2; ++n) acc[a][b][m][n] = (f32x4){0.f, 0.f, 0.f, 0.f};
    bf16x8 At[4][2], B0[2][2], B1[2][2];
    const char* cA = (const char*)g.A + (size_t)cur.pm * tstep; const char* cB = (const char*)g.Bt + (size_t)cur.pn * tstep;
    S.a_ready(cur);
    if constexpr (SP2) {
        PG8_STAGE(PG8_SB(0, 0), cB, voffB); PG8_STAGE(PG8_SB(0, 1), cB + hstep, voffB); PG8_STAGE(PG8_SA(0, 0), cA, voffA); PG8_STAGE(PG8_SA(0, 1), cA + hstep, voffA);
        if (wr == 1) PG8_BAR;
        PG8_WAIT_V(2); PG8_BAR;
        PG8_STAGE(PG8_SB(1, 0), cB + kstep, voffB); PG8_STAGE(PG8_SA(1, 0), cA + kstep, voffA); PG8_STAGE(PG8_SB(1, 1), cB + hstep + kstep, voffB);
        PG8_WAIT_V(6); PG8_BAR;
    } else {
        PG8_STAGE(PG8_SB(0, 0), cB, voffB); PG8_STAGE(PG8_SA(0, 0), cA, voffA); PG8_STAGE(PG8_SB(0, 1), cB + hstep, voffB); PG8_STAGE(PG8_SA(0, 1), cA + hstep, voffA);
        if (wr == 1) PG8_BAR;
        PG8_WAIT_V(4); PG8_BAR;
        PG8_STAGE(PG8_SB(1, 0), cB + kstep, voffB); PG8_STAGE(PG8_SA(1, 0), cA + kstep, voffA); PG8_STAGE(PG8_SB(1, 1), cB + hstep + kstep, voffB);
        PG8_WAIT_V(6); PG8_BAR;
    }
    for (;;) {
        const bool has_next = S.next(ui + 1, nxt);
        const char* nA = has_next ? (const char*)g.A + (size_t)nxt.pm * tstep : cA; const char* nB = has_next ? (const char*)g.Bt + (size_t)nxt.pn * tstep : cB;
        for (int t = 0; t < nt; t += 2) {
            const bool last = (t == nt - 2);
            const char* a1 = cA + (size_t)(t + 1) * kstep;
            const char* a2 = last ? nA : cA + (size_t)(t + 2) * kstep; const char* b2 = last ? nB : cB + (size_t)(t + 2) * kstep;
            const char* a3 = a2 + kstep; const char* b3 = b2 + kstep;
            if (last && has_next) S.a_ready(nxt);
            if constexpr (SP2) {
            PG8_LDB(B0, 0, 0); PG8_LDB(B1, 0, 1); PG8_SCHED; PG8_LDA(At, 0, 0); PG8_STAGE(PG8_SA(1, 1), a1 + hstep, voffA);
            PG8_WAIT_V(8); PG8_WAIT_L(0); PG8_BAR; PG8_MMA(0, 0, At, B0); PG8_MMA(0, 1, At, B1); PG8_BAR; PG8_SCHED;
            PG8_LDA(At, 0, 1); PG8_STAGE(PG8_SB(0, 0), b2, voffB); PG8_STAGE(PG8_SB(0, 1), b2 + hstep, voffB); PG8_STAGE(PG8_SA(0, 0), a2, voffA);
            PG8_WAIT_V(8); PG8_WAIT_L(0); PG8_BAR; PG8_MMA(1, 0, At, B0); PG8_MMA(1, 1, At, B1); PG8_BAR; PG8_SCHED;
            PG8_LDB(B0, 1, 0); PG8_LDB(B1, 1, 1); PG8_SCHED; PG8_LDA(At, 1, 0); PG8_STAGE(PG8_SA(0, 1), a2 + hstep, voffA);
            PG8_WAIT_V(8); PG8_WAIT_L(0); PG8_BAR; PG8_MMA(0, 0, At, B0); PG8_MMA(0, 1, At, B1); PG8_BAR; PG8_SCHED;
            PG8_LDA(At, 1, 1); PG8_STAGE(PG8_SB(1, 0), b3, voffB); PG8_STAGE(PG8_SB(1, 1), b3 + hstep, voffB); PG8_STAGE(PG8_SA(1, 0), a3, voffA);
            PG8_WAIT_V(8); PG8_WAIT_L(0); PG8_BAR; PG8_MMA(1, 0, At, B0); PG8_MMA(1, 1, At, B1); PG8_BAR; PG8_SCHED;
            } else {
            PG8_LDB(B0, 0, 0); PG8_SCHED; PG8_LDA(At, 0, 0); PG8_STAGE(PG8_SA(1, 1), a1 + hstep, voffA);
            PG8_WAIT_L(8); PG8_BAR; PG8_WAIT_L(0); PG8_MMA(0, 0, At, B0); PG8_BAR; PG8_SCHED;
            PG8_LDB(B1, 0, 1); PG8_STAGE(PG8_SB(0, 0), b2, voffB);
            PG8_BAR; PG8_WAIT_L(0); PG8_MMA(0, 1, At, B1); PG8_BAR;
            PG8_LDA(At, 0, 1); PG8_STAGE(PG8_SA(0, 0), a2, voffA);
            PG8_BAR; PG8_WAIT_L(0); PG8_MMA(1, 0, At, B0); PG8_BAR; PG8_SCHED;
            PG8_STAGE(PG8_SB(0, 1), b2 + hstep, voffB);
            PG8_WAIT_V(6); PG8_BAR; PG8_MMA(1, 1, At, B1); PG8_BAR;
            PG8_LDB(B0, 1, 0); PG8_SCHED; PG8_LDA(At, 1, 0); PG8_STAGE(PG8_SA(0, 1), a2 + hstep, voffA);
            PG8_WAIT_L(8); PG8_BAR; PG8_WAIT_L(0); PG8_MMA(0, 0, At, B0); PG8_BAR; PG8_SCHED;
            PG8_LDB(B1, 1, 1); PG8_STAGE(PG8_SB(1, 0), b3, voffB);
            PG8_BAR; PG8_WAIT_L(0); PG8_MMA(0, 1, At, B1); PG8_BAR;
            PG8_LDA(At, 1, 1); PG8_STAGE(PG8_SA(1, 0), a3, voffA);
            PG8_BAR; PG8_WAIT_L(0); PG8_MMA(1, 0, At, B0); PG8_BAR; PG8_SCHED;
            PG8_STAGE(PG8_SB(1, 1), b3 + hstep, voffB);
            PG8_WAIT_V(6); PG8_BAR; PG8_MMA(1, 1, At, B1); PG8_BAR;
            }
        }
        if constexpr (ALIGN_EPI) { if (wr == 0) PG8_BAR; }
        if constexpr (!Epi::AFTER_DRAIN) { E(acc, cur, wr, wc, fr, fq); S.done(cur); }
        if (!has_next) break;
#pragma unroll
        for (int a = 0; a < 2; ++a)
#pragma unroll
            for (int b = 0; b < 2; ++b)
#pragma unroll
                for (int m = 0; m < 4; ++m)
#pragma unroll
                    for (int n = 0; n < 2; ++n) acc[a][b][m][n] = (f32x4){0.f, 0.f, 0.f, 0.f};
        cur = nxt; cA = nA; cB = nB; ++ui;
        if constexpr (ALIGN_EPI) { if (wr == 1) PG8_BAR; }
    }
    PG8_WAIT_V(0);
    if constexpr (!ALIGN_EPI) { if (wr == 0) PG8_BAR; }
    PG8_BAR;
    if constexpr (Epi::AFTER_DRAIN) { E.fused(acc, cur, wr, wc, fr, fq, lds, wid, lane); S.done(cur); }
#undef PG8_SA
#undef PG8_SB
#undef PG8_STAGE
#undef PG8_LDA
#undef PG8_LDB
#undef PG8_MMA
#undef PG8_WAIT_V
#undef PG8_WAIT_L
#undef PG8_BAR
#undef PG8_SCHED
}
}
namespace pg8 {
constexpr float NORM_EPS = 1e-6f;
__device__ __forceinline__ float row_rstd(const float* ssp, int row) {
    const f32x4 a = *(const f32x4*)(ssp + (size_t)row * 16), b = *(const f32x4*)(ssp + (size_t)row * 16 + 4), c = *(const f32x4*)(ssp + (size_t)row * 16 + 8), d = *(const f32x4*)(ssp + (size_t)row * 16 + 12);
    const float s = ((a[0] + a[1]) + (a[2] + a[3])) + ((b[0] + b[1]) + (b[2] + b[3])) + ((c[0] + c[1]) + (c[2] + c[3])) + ((d[0] + d[1]) + (d[2] + d[3]));
    return __builtin_amdgcn_rsqf(s * (1.0f / 1024.0f) + NORM_EPS);
}
__device__ __forceinline__ float silu_mul(float g, float u) { return g * __builtin_amdgcn_rcpf(1.0f + __builtin_amdgcn_exp2f(-1.4426950408889634f * g)) * u; }

struct EpiGLU {
    static constexpr bool PERM = true, AFTER_DRAIN = false;
    bf16_t* act; const float* ssp; int ldc;
    __device__ __forceinline__ void operator()(const f32x4 (&acc)[2][2][4][2], const Unit& u, int wr, int wc, int fr, int fq) const {
        const int row0 = u.pm * BM + wr * 64 + fr, col0 = u.pn * 128 + wc * 32 + 8 * fq;
#pragma unroll
        for (int ai = 0; ai < 2; ++ai)
#pragma unroll
            for (int m = 0; m < 4; ++m) { const int row = row0 + ai * HALF + m * 16; const float rs = row_rstd(ssp, row);
                const f32x4 g0 = acc[ai][0][m][0] * rs, g1 = acc[ai][0][m][1] * rs, u0 = acc[ai][1][m][0] * rs, u1 = acc[ai][1][m][1] * rs;
                u32x4 w; w.x = cvt_pk_bf16(silu_mul(g0[0], u0[0]), silu_mul(g0[1], u0[1])); w.y = cvt_pk_bf16(silu_mul(g0[2], u0[2]), silu_mul(g0[3], u0[3]));
                w.z = cvt_pk_bf16(silu_mul(g1[0], u1[0]), silu_mul(g1[1], u1[1])); w.w = cvt_pk_bf16(silu_mul(g1[2], u1[2]), silu_mul(g1[3], u1[3]));
                *(u32x4*)(act + (size_t)row * ldc + col0) = w; }
    }
};
struct EpiRes {
    static constexpr bool PERM = true, AFTER_DRAIN = false;
    float* x; bf16_t* xb; float* ssq; float alpha;
    __device__ __forceinline__ void operator()(const f32x4 (&acc)[2][2][4][2], const Unit& u, int wr, int wc, int fr, int fq) const {
        const int row0 = u.pm * BM + wr * 64 + fr, col0 = u.pn * BM + wc * 32 + 8 * fq;
#pragma unroll
        for (int ai = 0; ai < 2; ++ai)
#pragma unroll
            for (int m = 0; m < 4; ++m) { const int row = row0 + ai * HALF + m * 16; float q = 0.f;
#pragma unroll
                for (int bj = 0; bj < 2; ++bj) { float* p = x + (size_t)row * 1024 + col0 + bj * HALF;
                    f32x4 a = *(const f32x4*)p, b = *(const f32x4*)(p + 4);
                    a = a + acc[ai][bj][m][0] * alpha; b = b + acc[ai][bj][m][1] * alpha;
                    *(f32x4*)p = a; *(f32x4*)(p + 4) = b;
                    q += ((a[0] * a[0] + a[1] * a[1]) + (a[2] * a[2] + a[3] * a[3])) + ((b[0] * b[0] + b[1] * b[1]) + (b[2] * b[2] + b[3] * b[3]));
                    u32x4 w; w.x = cvt_pk_bf16(a[0], a[1]); w.y = cvt_pk_bf16(a[2], a[3]); w.z = cvt_pk_bf16(b[0], b[1]); w.w = cvt_pk_bf16(b[2], b[3]);
                    *(u32x4*)(xb + (size_t)row * 1024 + col0 + bj * HALF) = w; }
                q += __shfl_xor(q, 16); q += __shfl_xor(q, 32);
                if (fq == 0) ssq[(size_t)row * 16 + u.pn * 4 + wc] = q;
                asm volatile("" ::: "memory"); }
    }
};
template <int MODE> struct EpiMix {
    static constexpr bool PERM = true, AFTER_DRAIN = false;
    const float* ssp;
    bf16_t *aq, *ak, *av, *iq, *pu, *mq, *ik; float* iw;
    const float *gq, *gk, *gmq;
    float c2;
    __device__ __forceinline__ void headnorm(const f32x4 (&acc)[2][2][4][2], int ai, int m, float rs, const float* g, float sc, bf16_t* dst, int fq, bool norm) const {
        f32x4 v[2][2];
#pragma unroll
        for (int bj = 0; bj < 2; ++bj)
#pragma unroll
            for (int n = 0; n < 2; ++n) v[bj][n] = acc[ai][bj][m][n] * rs;
        float r = 1.f;
        if (norm) { float s = 0.f;
#pragma unroll
            for (int bj = 0; bj < 2; ++bj)
#pragma unroll
                for (int n = 0; n < 2; ++n) s += (v[bj][n][0] * v[bj][n][0] + v[bj][n][1] * v[bj][n][1]) + (v[bj][n][2] * v[bj][n][2] + v[bj][n][3] * v[bj][n][3]);
            s += __shfl_xor(s, 16); s += __shfl_xor(s, 32);
            r = __builtin_amdgcn_rsqf(s * (1.0f / 64.0f) + NORM_EPS) * sc; }
#pragma unroll
        for (int bj = 0; bj < 2; ++bj) { f32x4 g0 = (f32x4){1.f, 1.f, 1.f, 1.f}, g1 = g0;
            if (norm) { g0 = *(const f32x4*)(g + bj * 32 + 8 * fq); g1 = *(const f32x4*)(g + bj * 32 + 8 * fq + 4); }
            const f32x4 a = v[bj][0] * g0 * r, b = v[bj][1] * g1 * r;
            u32x4 w; w.x = cvt_pk_bf16(a[0], a[1]); w.y = cvt_pk_bf16(a[2], a[3]); w.z = cvt_pk_bf16(b[0], b[1]); w.w = cvt_pk_bf16(b[2], b[3]);
            *(u32x4*)(dst + bj * 32 + 8 * fq) = w; }
    }
    __device__ __forceinline__ void plain(const f32x4 (&acc)[2][2][4][2], int ai, int m, float rs, bf16_t* dst  , int wc, int fq) const {
#pragma unroll
        for (int bj = 0; bj < 2; ++bj) { const f32x4 a = acc[ai][bj][m][0] * rs, b = acc[ai][bj][m][1] * rs;
            u32x4 w; w.x = cvt_pk_bf16(a[0], a[1]); w.y = cvt_pk_bf16(a[2], a[3]); w.z = cvt_pk_bf16(b[0], b[1]); w.w = cvt_pk_bf16(b[2], b[3]);
            *(u32x4*)(dst + bj * HALF + wc * 32 + 8 * fq) = w; }
    }
    __device__ __forceinline__ void operator()(const f32x4 (&acc)[2][2][4][2], const Unit& u, int wr, int wc, int fr, int fq) const {
        const int row0 = u.pm * BM + wr * 64 + fr, pn = u.pn;
#pragma unroll
        for (int ai = 0; ai < 2; ++ai)
#pragma unroll
            for (int m = 0; m < 4; ++m) { const int row = row0 + ai * HALF + m * 16; const float rs = row_rstd(ssp, row);
                if (MODE == 1) { const int layer = pn >> 1;
                    if ((pn & 1) == 0) headnorm(acc, ai, m, rs, gk + layer * 64, 1.0f, aq + ((size_t)layer * 512 + row) * 256 + wc * 64, fq, true);
                    else               headnorm(acc, ai, m, rs, gk, 1.0f, av + ((size_t)layer * 512 + row) * 256 + wc * 64, fq, false);
                } else {
                    if (pn < 2)       headnorm(acc, ai, m, rs, gq, c2, aq + (size_t)row * 512 + (pn * 4 + wc) * 64, fq, true);
                    else if (pn < 4)  headnorm(acc, ai, m, rs, gk, 1.0f, ak + (size_t)row * 512 + ((pn - 2) * 4 + wc) * 64, fq, true);
                    else if (pn < 6)  headnorm(acc, ai, m, rs, gk, 1.0f, av + (size_t)row * 512 + ((pn - 4) * 4 + wc) * 64, fq, false);
                    else if (pn == 6) plain(acc, ai, m, rs, iq + (size_t)row * 256, wc, fq);
                    else if (pn == 7) plain(acc, ai, m, rs, pu + (size_t)row * 256, wc, fq);
                    else if (pn == 8) headnorm(acc, ai, m, rs, gmq, c2, mq + (size_t)row * 256 + wc * 64, fq, true);
                    else {
                        if (wc < 2) { const f32x4 a = acc[ai][0][m][0] * rs, b = acc[ai][0][m][1] * rs;
                            u32x4 w; w.x = cvt_pk_bf16(a[0], a[1]); w.y = cvt_pk_bf16(a[2], a[3]); w.z = cvt_pk_bf16(b[0], b[1]); w.w = cvt_pk_bf16(b[2], b[3]);
                            *(u32x4*)(ik + (size_t)row * 64 + wc * 32 + 8 * fq) = w; }
                        else if (wc == 2 && fq == 0) { *(f32x4*)(iw + (size_t)row * 4) = acc[ai][0][m][0] * rs; }
                    }
                }
            }
    }
};
}
constexpr int NWAVES = 8;
constexpr int BATCH = 2, SEQ = 16384, DM = 1024, DEPTH = 4, T = BATCH * SEQ;
constexpr int DFF = 2816, NGU = 2 * DFF, DIN = 2372, NIN = 2560, NMEM = 256, NSEL = 256;
constexpr float C2 = 0.125f * 1.4426950408889634f;
constexpr size_t MiB = 1u << 20;
constexpr size_t WS_CTL = 0, CTL_ZERO_BYTES = 1 * MiB;
constexpr size_t WS_SSP = 1 * MiB;
constexpr size_t WS_SSM = 3 * MiB;
constexpr size_t WS_MEMB = 3 * MiB + 64 * 1024;
constexpr size_t WS_WKV = 5 * MiB;
constexpr size_t WS_MEMK = 9 * MiB, WS_MEMV = 10 * MiB;
constexpr size_t WS_W = 12 * MiB;
constexpr size_t WL_1GU = 0, WL_1D = 11 * MiB, WL_IN = 11 * MiB + 5632 * 1024, WL_OUT = WL_IN + 5 * MiB, WL_2GU = WL_OUT + 2 * MiB, WL_2D = WL_2GU + 11 * MiB, WL_STRIDE = 40 * MiB;
static_assert(WL_2D + (size_t)DM * DFF * 2 <= WL_STRIDE, "layer weights");
constexpr size_t WS_XB = 172 * MiB;
constexpr size_t WS_CAT = 236 * MiB;
constexpr size_t WS_ACT = 300 * MiB;
constexpr size_t WS_AQ = WS_ACT, WS_AK = WS_AQ + 32 * MiB, WS_AV = WS_AK + 32 * MiB, WS_IQ = WS_AV + 32 * MiB, WS_PU = WS_IQ + 16 * MiB, WS_MQ = WS_PU + 16 * MiB, WS_IK = WS_MQ + 16 * MiB, WS_IW = WS_IK + 4 * MiB;
constexpr size_t WS_END = WS_ACT + 176 * MiB;
static_assert(WS_IW + (size_t)T * 16 <= WS_END && WS_END <= 512 * MiB, "d_ws map");
constexpr int CW_BAR = 4096;
constexpr int RING_OFF = 0, RING_BYTES = 131072;
constexpr int LDSCTL_OFF = RING_BYTES, MISC_OFF = LDSCTL_OFF + 320;
constexpr int LDS_BYTES = 147456;
static_assert(MISC_OFF + 128 <= LDS_BYTES, "LDS map");
#define GAS __attribute__((address_space(1)))
#define LAS __attribute__((address_space(3)))
typedef unsigned short bf16;
typedef unsigned v4u __attribute__((ext_vector_type(4)));
typedef float f32x4 __attribute__((ext_vector_type(4)));
typedef short bf16x8 __attribute__((ext_vector_type(8)));
typedef GAS unsigned gu32;
typedef GAS unsigned long long gu64;
#define RLX_AGENT __ATOMIC_RELAXED, __HIP_MEMORY_SCOPE_AGENT
#define LDS_WAIT() asm volatile("s_waitcnt lgkmcnt(0)" ::: "memory")
#define VM_WAIT() asm volatile("s_waitcnt vmcnt(0)" ::: "memory")
__device__ __forceinline__ unsigned long long rt() { return __builtin_amdgcn_s_memrealtime(); }
__device__ __forceinline__ unsigned f2bf(float f) { unsigned u = __builtin_bit_cast(unsigned, f); return (u + 0x7fffu + ((u >> 16) & 1u)) >> 16; }
__device__ __forceinline__ unsigned pk2(float lo, float hi) { return f2bf(lo) | (f2bf(hi) << 16); }

#define XB_TMO      128
#define XB_XCNT(j)  (256  + 64 * (j))
#define XB_XSUB(j)  (1280 + 64 * (j))
#define XB_XGEN(j)  (2304 + 64 * (j))
#define XB_TOP      3328
#define XB_TOPGEN   3392
#define XCD_BAR_WORDS 3456
#define XB_SPIN_CAP (1u << 18)

__device__ __forceinline__ unsigned xb_ld(unsigned* p)              { return __hip_atomic_load(p, __ATOMIC_RELAXED, __HIP_MEMORY_SCOPE_AGENT); }
__device__ __forceinline__ unsigned xb_add(unsigned* p, unsigned v) { return __hip_atomic_fetch_add(p, v, __ATOMIC_RELAXED, __HIP_MEMORY_SCOPE_AGENT); }
__device__ __forceinline__ unsigned xb_xcc_id() { return (unsigned)__builtin_amdgcn_s_getreg((3 << 11) | 20) & 0xFu; }
#define XB_SPIN(cond, bar) do { unsigned _sp = 0; while (cond) { __builtin_amdgcn_s_sleep(1); \
    if ((++_sp & 255u) == 0u) { if (xb_ld(&(bar)[XB_TMO])) break; if (_sp > XB_SPIN_CAP) { atomicAdd(&(bar)[XB_TMO], 1u); break; } } } } while (0)

struct XcdBarrier {
    unsigned* bar; unsigned x;
    volatile LAS unsigned* st;
};

__device__ __forceinline__ XcdBarrier xcd_barrier_post(unsigned* bar, volatile LAS unsigned* st) {
    XcdBarrier b; b.bar = bar; b.x = xb_xcc_id(); b.st = st;
    if (threadIdx.x == 0) (void)xb_add(&bar[XB_XCNT(b.x)], 1u);
    return b;
}
__device__ __forceinline__ void xcd_barrier_complete(unsigned* bar, unsigned x, unsigned& nloc, unsigned& nx) {
    const unsigned G = gridDim.x * gridDim.y * gridDim.z;
    unsigned sum, cnt, mine, sp = 0u;
    for (;;) {
        sum = 0u; cnt = 0u; mine = 0u;
#pragma unroll
        for (unsigned j = 0; j < 16; ++j) { const unsigned c = xb_ld(&bar[XB_XCNT(j)]); sum += c; cnt += (c > 0u) ? 1u : 0u; mine = (j == x) ? c : mine; }
        if (sum == G) break;
        __builtin_amdgcn_s_sleep(1);
        if ((++sp & 255u) == 0u) { if (xb_ld(&bar[XB_TMO])) break; if (sp > XB_SPIN_CAP) { atomicAdd(&bar[XB_TMO], 1u); break; } }
    }
    nloc = mine > 0u ? mine : 1u; nx = cnt > 0u ? cnt : 1u;
}

__device__ __forceinline__ void xcd_barrier(const XcdBarrier& b) {
    asm volatile("s_waitcnt vmcnt(0)" ::: "memory");
    __syncthreads();
    if (threadIdx.x == 0) {
        unsigned* bar = b.bar;
        __builtin_amdgcn_s_waitcnt(0);
        unsigned nloc = b.st[0], nx = b.st[1];
        if (nloc == 0u) { xcd_barrier_complete(bar, b.x, nloc, nx); b.st[0] = nloc; b.st[1] = nx; }
        const unsigned old = xb_add(&bar[XB_XSUB(b.x)], 1u);
        const unsigned gen = old / nloc;
        if (old + 1u == (gen + 1u) * nloc) {
            __builtin_amdgcn_fence(__ATOMIC_RELEASE, "agent");
            asm volatile("s_waitcnt vmcnt(0)" ::: "memory");
            const unsigned og = xb_add(&bar[XB_TOP], 1u);
            const unsigned tg = og / nx;
            if (og + 1u == (tg + 1u) * nx) xb_add(&bar[XB_TOPGEN], 1u);
            else XB_SPIN(xb_ld(&bar[XB_TOPGEN]) == tg, bar);
            __builtin_amdgcn_fence(__ATOMIC_ACQUIRE, "agent");
            xb_add(&bar[XB_XGEN(b.x)], 1u);
            asm volatile("s_waitcnt vmcnt(0)" ::: "memory");
        } else {
            XB_SPIN(xb_ld(&bar[XB_XGEN(b.x)]) == gen, bar);
            __builtin_amdgcn_fence(__ATOMIC_ACQUIRE, "agent");
            asm volatile("s_waitcnt vmcnt(0)" ::: "memory");
        }
    }
    __syncthreads();
}

struct Frame {
    LAS unsigned char* lds;
    volatile LAS unsigned* MISC;
    gu32* ctl;
    int tid, lane, wave, G;
    unsigned char* ws;
    const float* in[21];
    float* out;
};
__device__ __forceinline__ float bf2f(unsigned b) { return __builtin_bit_cast(float, b << 16); }
__device__ __forceinline__ float bflo(unsigned w) { return __builtin_bit_cast(float, w << 16); }
__device__ __forceinline__ float bfhi(unsigned w) { return __builtin_bit_cast(float, w & 0xffff0000u); }
__device__ __forceinline__ float wave_sum(float v) {
#pragma unroll
    for (int o = 1; o < 64; o <<= 1) v += __shfl_xor(v, o);
    return v;
}
template <class RowMap>
__device__ __forceinline__ void tr_item(const float* W, int K, int N, const float* gain, bf16* WT, RowMap rm, LAS float* scr, int item, int lane) {
    const int nblk = (N + 31) / 32, kb = item / nblk, nb = item % nblk, k0 = 64 * kb, n0 = 32 * nb;
    const int nn = n0 + (lane & 31);
#pragma unroll 8
    for (int i = 0; i < 32; ++i) { const int kk = 2 * i + (lane >> 5); float v = (nn < N) ? W[(size_t)(k0 + kk) * N + nn] : 0.f; if (gain) v *= gain[k0 + kk]; scr[kk * 33 + (lane & 31)] = v; }
    LDS_WAIT(); asm volatile("" ::: "memory");
    const int c = lane & 7;
#pragma unroll
    for (int j = 0; j < 4; ++j) { const int n = (lane >> 3) + 8 * j; const LAS float* s = scr + (8 * c) * 33 + n;
        v4u o; o.x = pk2(s[0 * 33], s[1 * 33]); o.y = pk2(s[2 * 33], s[3 * 33]); o.z = pk2(s[4 * 33], s[5 * 33]); o.w = pk2(s[6 * 33], s[7 * 33]);
        if (n0 + n < N) *(GAS v4u*)(WT + (size_t)rm(n0 + n) * K + k0 + 8 * c) = o; }
    LDS_WAIT(); asm volatile("" ::: "memory");
}
__device__ __forceinline__ void tr_item_pool(const float* Wout, const float* wpool  , const float* pscale  , bf16* WT, LAS float* scr, int g, int nb, int lane) {
    const int k0 = 512 + 64 * g, n0 = 32 * nb;
#pragma unroll 8
    for (int i = 0; i < 32; ++i) { const int kk = 2 * i + (lane >> 5); scr[kk * 33 + (lane & 31)] = Wout[(size_t)(k0 + kk) * 1024 + n0 + (lane & 31)] * pscale[64 * g + kk]; }
    LDS_WAIT(); asm volatile("" ::: "memory");
    float o[32];
    const int nl = lane & 31;
#pragma unroll
    for (int i = 0; i < 32; ++i) { const float* wr_ = wpool + (size_t)(g * 64 + 2 * i + (lane >> 5)) * 64; float a = 0.f;
        for (int d4 = 0; d4 < 16; ++d4) { const f32x4 w = *(const f32x4*)(wr_ + 4 * d4);
            a += (w[0] * scr[(4 * d4) * 33 + nl] + w[1] * scr[(4 * d4 + 1) * 33 + nl]) + (w[2] * scr[(4 * d4 + 2) * 33 + nl] + w[3] * scr[(4 * d4 + 3) * 33 + nl]); }
        o[i] = a; }
    LDS_WAIT(); asm volatile("" ::: "memory");
#pragma unroll
    for (int i = 0; i < 32; ++i) scr[(2 * i + (lane >> 5)) * 33 + (lane & 31)] = o[i];
    LDS_WAIT(); asm volatile("" ::: "memory");
    const int c = lane & 7;
#pragma unroll
    for (int j = 0; j < 4; ++j) { const int n = (lane >> 3) + 8 * j; const LAS float* s = scr + (8 * c) * 33 + n;
        v4u o2; o2.x = pk2(s[0 * 33], s[1 * 33]); o2.y = pk2(s[2 * 33], s[3 * 33]); o2.z = pk2(s[4 * 33], s[5 * 33]); o2.w = pk2(s[6 * 33], s[7 * 33]);
        *(GAS v4u*)(WT + (size_t)(n0 + n) * 1024 + k0 + 8 * c) = o2; }
    LDS_WAIT(); asm volatile("" ::: "memory");
}
struct RmNat { int off; __device__ __forceinline__ int operator()(int n) const { return n + off; } };
struct RmGate { int off; __device__ __forceinline__ int operator()(int n) const { return (n >> 7) * 256 + off + (n & 127); } };
__device__ __forceinline__ int headperm(int c) { const int h = c >> 6, d = c & 63; return 256 * (h >> 2) + 128 * (d >> 5) + 32 * (h & 3) + (d & 31); }
struct RmIn { __device__ __forceinline__ int operator()(int n) const {
    if (n < 1536) return (n / 512) * 512 + headperm(n % 512);
    if (n < 1792) return n;
    if (n < 1856) return 2304 + (n - 1792);
    if (n < 1860) return 2304 + 64 + (n - 1856);
    if (n < 2116) return 1792 + (n - 1860);
    return 2048 + headperm(n - 2116); } };
struct RmKV { int layer; __device__ __forceinline__ int operator()(int n) const { return layer * 512 + (n >> 8) * 256 + headperm(n & 255); } };
__device__ __forceinline__ void p0_prologue(Frame& F) {
    LAS float* scr = (LAS float*)(F.lds + RING_OFF + F.wave * 16384);
    const int gw = blockIdx.x * NWAVES + F.wave, NGW = F.G * NWAVES, lane = F.lane;
    constexpr int I_GU = (DM / 64) * (DFF / 32), I_D = (DFF / 64) * (DM / 32), I_IN = (DM / 64) * ((DIN + 31) / 32), I_OUT = (DM / 64) * (DM / 32), I_KV = (DM / 64) * (512 / 32);
    constexpr int PER_LAYER = 4 * I_GU + 2 * I_D + I_IN + I_OUT + I_KV;
    for (int it = gw; it < DEPTH * PER_LAYER; it += NGW) {
        const int l = it / PER_LAYER; int r = it % PER_LAYER;
        unsigned char* wl = F.ws + WS_W + (size_t)l * WL_STRIDE;
        if (r < I_GU) { tr_item(F.in[3] + (size_t)l * DM * DFF, DM, DFF, F.in[2] + l * DM, (bf16*)(wl + WL_1GU), RmGate{0}, scr, r, lane); continue; } r -= I_GU;
        if (r < I_GU) { tr_item(F.in[4] + (size_t)l * DM * DFF, DM, DFF, F.in[2] + l * DM, (bf16*)(wl + WL_1GU), RmGate{128}, scr, r, lane); continue; } r -= I_GU;
        if (r < I_D)  { tr_item(F.in[5] + (size_t)l * DFF * DM, DFF, DM, nullptr, (bf16*)(wl + WL_1D), RmNat{0}, scr, r, lane); continue; } r -= I_D;
        if (r < I_GU) { tr_item(F.in[18] + (size_t)l * DM * DFF, DM, DFF, F.in[17] + l * DM, (bf16*)(wl + WL_2GU), RmGate{0}, scr, r, lane); continue; } r -= I_GU;
        if (r < I_GU) { tr_item(F.in[19] + (size_t)l * DM * DFF, DM, DFF, F.in[17] + l * DM, (bf16*)(wl + WL_2GU), RmGate{128}, scr, r, lane); continue; } r -= I_GU;
        if (r < I_D)  { tr_item(F.in[20] + (size_t)l * DFF * DM, DFF, DM, nullptr, (bf16*)(wl + WL_2D), RmNat{0}, scr, r, lane); continue; } r -= I_D;
        if (r < I_IN) { tr_item(F.in[8] + (size_t)l * DM * DIN, DM, DIN, F.in[6] + l * DM, (bf16*)(wl + WL_IN), RmIn{}, scr, r, lane); continue; } r -= I_IN;
        if (r < I_OUT) { const int kb = r / 32, nb = r % 32;
            if (kb >= 8 && kb < 12) tr_item_pool(F.in[16] + (size_t)l * DM * DM, F.in[11] + (size_t)l * 4 * 64 * 64, F.in[12] + l * 256, (bf16*)(wl + WL_OUT), scr, kb - 8, nb, lane);
            else tr_item(F.in[16] + (size_t)l * DM * DM, DM, DM, nullptr, (bf16*)(wl + WL_OUT), RmNat{0}, scr, r, lane);
            continue; } r -= I_OUT;
        tr_item(F.in[13] + (size_t)l * DM * 512, DM, 512, F.in[7] + l * DM, (bf16*)(F.ws + WS_WKV), RmKV{l}, scr, r, lane);
    }
    for (int it = gw; it < DEPTH * 188; it += NGW) { const int l = it / 188, rr = 2304 + 68 + it % 188;
        GAS v4u* p = (GAS v4u*)((bf16*)(F.ws + WS_W + (size_t)l * WL_STRIDE + WL_IN) + (size_t)rr * DM); p[lane] = (v4u){0u, 0u, 0u, 0u}; p[lane + 64] = (v4u){0u, 0u, 0u, 0u}; }
    for (int m = gw; m < T + 512; m += NGW) {
        const bool ismem = m >= T; const int row = ismem ? m - T : m;
        const GAS f32x4* xr = (const GAS f32x4*)((ismem ? F.in[1] : F.in[0]) + (size_t)row * DM) + lane;
        f32x4 v[4]; float s = 0.f;
#pragma unroll
        for (int j = 0; j < 4; ++j) { v[j] = xr[64 * j]; s += (v[j][0] * v[j][0] + v[j][1] * v[j][1]) + (v[j][2] * v[j][2] + v[j][3] * v[j][3]); }
        s = wave_sum(s);
        float* ssp = (float*)(F.ws + (ismem ? WS_SSM : WS_SSP)) + (size_t)row * 16;
        if (lane < 16) ssp[lane] = (lane == 0) ? s : 0.f;
        GAS unsigned long long* o8 = (GAS unsigned long long*)((bf16*)(F.ws + (ismem ? WS_MEMB : WS_XB)) + (size_t)row * DM) + lane;
#pragma unroll
        for (int j = 0; j < 4; ++j) o8[64 * j] = (unsigned long long)pk2(v[j][0], v[j][1]) | ((unsigned long long)pk2(v[j][2], v[j][3]) << 32);
        if (!ismem) { GAS f32x4* xo = (GAS f32x4*)(F.out + (size_t)row * DM) + lane;
#pragma unroll
            for (int j = 0; j < 4; ++j) xo[64 * j] = v[j]; }
    }
}

__device__ __forceinline__ unsigned block_excl_scan(unsigned v, LAS unsigned* wsum, int lane, int wave) {
    unsigned x = v;
#pragma unroll
    for (int o = 1; o < 64; o <<= 1) { const unsigned y = __shfl_up(x, o); if (lane >= o) x += y; }
    if (lane == 63) wsum[wave] = x;
    __syncthreads();
    unsigned base = 0;
#pragma unroll
    for (int w = 0; w < NWAVES; ++w) { const unsigned s = wsum[w]; if (w < wave) base += s; }
    __syncthreads();
    return base + x - v;
}
__device__ __forceinline__ void topk_phase_v1(Frame& F) {
    int tid_ = F.tid; asm volatile("" : "+v"(tid_)); unsigned char* ws_ = F.ws; asm volatile("" : "+s"(ws_));
    const int tid = tid_, lane = tid & 63, wave = __builtin_amdgcn_readfirstlane(tid >> 6);
    LAS unsigned* sc = (LAS unsigned*)(F.lds);
    LAS float* qs = (LAS float*)(F.lds + 65536);
    LAS unsigned* hist = (LAS unsigned*)(F.lds + 65536 + 1024);
    LAS unsigned* wsum = hist + 256;
    LAS unsigned* sel = wsum + 8;
    LAS unsigned* gtw = sel + 8;
    LAS unsigned* eqw = gtw + 512;
    const bf16* IQ = (const bf16*)(ws_ + WS_IQ); const bf16* IK = (const bf16*)(ws_ + WS_IK); const float* IW = (const float*)(ws_ + WS_IW);
    unsigned* BM = (unsigned*)(ws_ + WS_XB);
    for (int qi = blockIdx.x; qi < T; qi += F.G) {
        const int b = qi >> 14, t = qi & (SEQ - 1), N = t + 1;
        unsigned* bmrow = BM + (size_t)qi * 512;
        if (N <= NSEL) { const int lo = 32 * tid; unsigned bits = 0u; if (lo + 31 <= t) bits = 0xffffffffu; else if (lo <= t) bits = (1u << (t - lo + 1)) - 1u; bmrow[tid] = bits; continue; }
        if (tid < 256) qs[tid] = bf2f(IQ[(size_t)qi * 256 + tid]);
        const f32x4 wv = *(const f32x4*)(IW + (size_t)qi * 4);
        __syncthreads();
        for (int s = tid; s < N; s += 512) {
            const v4u* kr = (const v4u*)(IK + ((size_t)b * SEQ + s) * 64);
            float d0 = 0.f, d1 = 0.f, d2 = 0.f, d3 = 0.f;
#pragma unroll 1
            for (int c = 0; c < 8; ++c) { const v4u kk = kr[c]; float kf[8] = {bflo(kk.x), bfhi(kk.x), bflo(kk.y), bfhi(kk.y), bflo(kk.z), bfhi(kk.z), bflo(kk.w), bfhi(kk.w)};
#pragma unroll
                for (int e = 0; e < 8; ++e) { d0 += kf[e] * qs[8 * c + e]; d1 += kf[e] * qs[64 + 8 * c + e]; d2 += kf[e] * qs[128 + 8 * c + e]; d3 += kf[e] * qs[192 + 8 * c + e]; } }
            const float score = (wv[0] * fmaxf(d0, 0.f) + wv[1] * fmaxf(d1, 0.f)) + (wv[2] * fmaxf(d2, 0.f) + wv[3] * fmaxf(d3, 0.f));
            unsigned u = __builtin_bit_cast(unsigned, score); if (u == 0x80000000u) u = 0u;
            u = (u & 0x80000000u) ? ~u : (u | 0x80000000u);
            sc[s] = u;
        }
        __syncthreads();
        unsigned prefix = 0u, kk = NSEL;
        for (int pass = 0; pass < 4; ++pass) {
            const int shift = 24 - 8 * pass;
            if (tid < 256) hist[tid] = 0u;
            __syncthreads();
            for (int s = tid; s < N; s += 512) { const unsigned u = sc[s]; const bool in = (pass == 0) ? true : ((u >> ((shift + 8) & 31)) == prefix); if (in) atomicAdd((unsigned*)&hist[(u >> shift) & 255u], 1u); }
            __syncthreads();
            const unsigned v = tid < 256 ? hist[255 - tid] : 0u;
            const unsigned ex = block_excl_scan(v, wsum, lane, wave);
            if (tid < 256 && ex < kk && ex + v >= kk) { sel[0] = (prefix << 8) | (unsigned)(255 - tid); sel[1] = kk - ex; }
            __syncthreads();
            prefix = sel[0]; kk = sel[1];
            __syncthreads();
        }
        for (int j = 0; j * 512 < N; ++j) { const int s = j * 512 + tid; const unsigned u = s < N ? sc[s] : 0u;
            const unsigned long long bg = __ballot(s < N && u > prefix), be = __ballot(s < N && u == prefix);
            if (lane == 0) { gtw[j * 16 + wave * 2] = (unsigned)bg; gtw[j * 16 + wave * 2 + 1] = (unsigned)(bg >> 32); eqw[j * 16 + wave * 2] = (unsigned)be; eqw[j * 16 + wave * 2 + 1] = (unsigned)(be >> 32); } }
        __syncthreads();
        const bool live = 32 * tid < N;
        const unsigned gt = live ? gtw[tid] : 0u, eq = live ? eqw[tid] : 0u;
        const unsigned pre = block_excl_scan(__builtin_popcount(eq), wsum, lane, wave);
        int r = (int)kk - (int)pre; unsigned keep = 0u, e = eq;
        while (e != 0u && r > 0) { const unsigned low = e & (0u - e); keep |= low; e ^= low; --r; }
        bmrow[tid] = gt | keep;
        __syncthreads();
    }
}

template <bool MEM>
__device__ __forceinline__ void attn_phase_v1(Frame& F, int layer) {
    int tid_ = F.tid; asm volatile("" : "+v"(tid_)); unsigned char* ws_ = F.ws; asm volatile("" : "+s"(ws_));
    const int lane = tid_ & 63, wave = __builtin_amdgcn_readfirstlane(tid_ >> 6);
    LAS unsigned short* lst = (LAS unsigned short*)(F.lds + wave * 8704);
    LAS float* lg = (LAS float*)(F.lds + wave * 8704 + 512);
    const int gw = blockIdx.x * NWAVES + wave, NGW = F.G * NWAVES;
    const bf16* Qb = (const bf16*)(ws_ + (MEM ? WS_MQ : WS_AQ)); const bf16* Kb = (const bf16*)(ws_ + (MEM ? WS_MEMK : WS_AK)); const bf16* Vb = (const bf16*)(ws_ + (MEM ? WS_MEMV : WS_AV));
    const unsigned* BM = (const unsigned*)(ws_ + WS_XB); bf16* CAT = (bf16*)(ws_ + WS_CAT);
    constexpr int NQ = MEM ? 2 : 1, W = MEM ? 256 : 512;
    const int l8 = MEM ? (lane & 31) : lane, grp = lane >> 3;
    for (int q0 = gw * NQ; q0 < T; q0 += NGW * NQ) {
        const int q = q0 + (MEM ? (lane >> 5) : 0), b = q >> 14, t = q & (SEQ - 1);
        int nsel = NMEM;
        if (!MEM) { const unsigned* bm = BM + (size_t)q * 512; const int nwords = (t >> 5) + 1; int cnt = 0;
            for (int w0 = 0; w0 < nwords; w0 += 64) { const int w = w0 + lane; unsigned bits = (w < nwords) ? bm[w] : 0u; const int c = __builtin_popcount(bits);
                int x = c;
#pragma unroll
                for (int o = 1; o < 64; o <<= 1) { const int y = __shfl_up(x, o); if (lane >= o) x += y; }
                int pos = cnt + x - c; cnt += __shfl(x, 63);
                while (bits) { const int i = __builtin_ctz(bits); bits &= bits - 1u; lst[pos++] = (unsigned short)(32 * w + i); } }
            nsel = cnt; }
        const v4u qv = *(const v4u*)(Qb + (size_t)q * W + 8 * l8);
        const float qf[8] = {bflo(qv.x), bfhi(qv.x), bflo(qv.y), bfhi(qv.y), bflo(qv.z), bfhi(qv.z), bflo(qv.w), bfhi(qv.w)};
        const bf16* kbase = MEM ? Kb + ((size_t)(layer * 2 + b) * 256) * 256 + 8 * l8 : Kb + ((size_t)b * SEQ) * 512 + 8 * l8;
        const bf16* vbase = MEM ? Vb + ((size_t)(layer * 2 + b) * 256) * 256 + 8 * l8 : Vb + ((size_t)b * SEQ) * 512 + 8 * l8;
        float mx = -INFINITY;
#pragma unroll 4
        for (int j = 0; j < nsel; ++j) { const int idx = MEM ? j : (int)lst[j];
            const v4u kv = *(const v4u*)(kbase + (size_t)idx * W);
            float d = (qf[0] * bflo(kv.x) + qf[1] * bfhi(kv.x)) + (qf[2] * bflo(kv.y) + qf[3] * bfhi(kv.y)) + (qf[4] * bflo(kv.z) + qf[5] * bfhi(kv.z)) + (qf[6] * bflo(kv.w) + qf[7] * bfhi(kv.w));
            d += __shfl_xor(d, 1); d += __shfl_xor(d, 2); d += __shfl_xor(d, 4);
            mx = fmaxf(mx, d);
            if ((lane & 7) == 0) lg[grp * 256 + j] = d; }
        float sum = 0.f, o[8] = {0.f, 0.f, 0.f, 0.f, 0.f, 0.f, 0.f, 0.f};
#pragma unroll 4
        for (int j = 0; j < nsel; ++j) { const int idx = MEM ? j : (int)lst[j];
            const v4u vv = *(const v4u*)(vbase + (size_t)idx * W);
            const float p = __builtin_amdgcn_exp2f(lg[grp * 256 + j] - mx); sum += p;
            o[0] += p * bflo(vv.x); o[1] += p * bfhi(vv.x); o[2] += p * bflo(vv.y); o[3] += p * bfhi(vv.y); o[4] += p * bflo(vv.z); o[5] += p * bfhi(vv.z); o[6] += p * bflo(vv.w); o[7] += p * bfhi(vv.w); }
        const float inv = 1.0f / sum;
        v4u ov; ov.x = pk2(o[0] * inv, o[1] * inv); ov.y = pk2(o[2] * inv, o[3] * inv); ov.z = pk2(o[4] * inv, o[5] * inv); ov.w = pk2(o[6] * inv, o[7] * inv);
        *(v4u*)(CAT + (size_t)q * 1024 + (MEM ? 768 : 0) + 8 * l8) = ov;
    }
}
__device__ __forceinline__ void pool_phase(Frame& F) {
    int tid_ = F.tid; asm volatile("" : "+v"(tid_)); unsigned char* ws_ = F.ws; asm volatile("" : "+s"(ws_));
    const bf16* PU = (const bf16*)(ws_ + WS_PU); bf16* CAT = (bf16*)(ws_ + WS_CAT);
    for (int it = blockIdx.x * 512 + tid_; it < T * 32; it += F.G * 512) {
        const int q = it >> 5, ch = it & 31, t = q & (SEQ - 1), g = ch >> 3, win = 2 << g, n = (t + 1 < win) ? t + 1 : win;
        float a[8] = {0.f, 0.f, 0.f, 0.f, 0.f, 0.f, 0.f, 0.f}, u0[8];
        for (int j = 0; j < n; ++j) { const v4u v = *(const v4u*)(PU + (size_t)(q - j) * 256 + 8 * ch);
            const float f[8] = {bflo(v.x), bfhi(v.x), bflo(v.y), bfhi(v.y), bflo(v.z), bfhi(v.z), bflo(v.w), bfhi(v.w)};
#pragma unroll
            for (int e = 0; e < 8; ++e) { a[e] += f[e]; if (j == 0) u0[e] = f[e]; } }
        const float inv = 1.0f / (float)n;
        v4u o; o.x = pk2(a[0] * inv - u0[0], a[1] * inv - u0[1]); o.y = pk2(a[2] * inv - u0[2], a[3] * inv - u0[3]); o.z = pk2(a[4] * inv - u0[4], a[5] * inv - u0[5]); o.w = pk2(a[6] * inv - u0[6], a[7] * inv - u0[7]);
        *(v4u*)(CAT + (size_t)q * 1024 + 512 + 8 * ch) = o;
    }
}
struct Args { const float* in[21]; float* out; unsigned char* ws; };
__global__ void __launch_bounds__(NWAVES * 64, 2) fwd_kernel(Args args) {
    extern __shared__ __attribute__((aligned(16))) unsigned char lds[];
    Frame F;
    F.lds = (LAS unsigned char*)lds;
    F.MISC = (volatile LAS unsigned*)(F.lds + MISC_OFF);
    F.tid = threadIdx.x; F.lane = F.tid & 63; F.wave = __builtin_amdgcn_readfirstlane(F.tid >> 6);
    F.G = gridDim.x; F.ws = args.ws; F.out = args.out;
#pragma unroll
    for (int i = 0; i < 21; ++i) F.in[i] = args.in[i];
    F.ctl = (gu32*)(F.ws + WS_CTL);
    for (int u = F.tid; u < (LDS_BYTES - LDSCTL_OFF) / 4; u += NWAVES * 64) ((LAS unsigned*)(F.lds + LDSCTL_OFF))[u] = 0u;
    __syncthreads();
    XcdBarrier bar = xcd_barrier_post((unsigned*)(F.ctl + CW_BAR), F.MISC + 8);
#define GRID_BAR() xcd_barrier(bar)
    bf16* XB = (bf16*)(F.ws + WS_XB); bf16* ACT = (bf16*)(F.ws + WS_ACT); bf16* CAT = (bf16*)(F.ws + WS_CAT); float* SSP = (float*)(F.ws + WS_SSP);
    LAS unsigned char* ring = F.lds + RING_OFF;

#ifndef NO_P0
    p0_prologue(F);
#endif
    GRID_BAR();
    {
        pg8::Gemm g{(const bf16*)(F.ws + WS_MEMB), (const bf16*)(F.ws + WS_WKV), 512, DEPTH * 512, DM}; pg8::StaticOrder S; S.init(512, DEPTH * 512, F.G, (int)blockIdx.x);
        pg8::EpiMix<1> E{(const float*)(F.ws + WS_SSM), (bf16*)(F.ws + WS_MEMK), nullptr, (bf16*)(F.ws + WS_MEMV), nullptr, nullptr, nullptr, nullptr, nullptr, nullptr, F.in[15], nullptr, 1.0f};
#if (SITE_MASK >> 0) & 1
        pg8::gemm_phase<pg8::EpiMix<1>, pg8::StaticOrder, true, true>(ring, g, S, E);
#endif
    }
    for (int l = 0; l < DEPTH; ++l) {
        unsigned char* wl = F.ws + WS_W + (size_t)l * WL_STRIDE;
        {
            pg8::Gemm g{XB, (const bf16*)(wl + WL_1GU), T, NGU, DM}; pg8::StaticOrder S; S.init(T, NGU, F.G, (int)blockIdx.x);
            pg8::EpiGLU E{ACT, SSP, DFF};
#if (SITE_MASK >> 1) & 1
#if (SITE_MASK >> 5) & 1
            pg8::gemm_phase<pg8::EpiGLU, pg8::StaticOrder, true, true>(ring, g, S, E);
#endif
#endif
        }
        GRID_BAR();
        {
            pg8::Gemm g{ACT, (const bf16*)(wl + WL_1D), T, DM, DFF}; pg8::StaticOrder S; S.init(T, DM, F.G, (int)blockIdx.x);
            pg8::EpiRes E{F.out, XB, SSP, 0.5f};
#if (SITE_MASK >> 2) & 1
#if (SITE_MASK >> 4) & 1
#if (SITE_MASK >> 6) & 1
            pg8::gemm_phase<pg8::EpiRes, pg8::StaticOrder, true, true>(ring, g, S, E);
#endif
#endif
#endif
        }
        GRID_BAR();
        {
            pg8::Gemm g{XB, (const bf16*)(wl + WL_IN), T, NIN, DM}; pg8::StaticOrder S; S.init(T, NIN, F.G, (int)blockIdx.x);
            pg8::EpiMix<0> E{SSP, (bf16*)(F.ws + WS_AQ), (bf16*)(F.ws + WS_AK), (bf16*)(F.ws + WS_AV), (bf16*)(F.ws + WS_IQ), (bf16*)(F.ws + WS_PU), (bf16*)(F.ws + WS_MQ), (bf16*)(F.ws + WS_IK), (float*)(F.ws + WS_IW),
                             F.in[9] + l * 64, F.in[10] + l * 64, F.in[14] + l * 64, C2};
#if (SITE_MASK >> 3) & 1
            pg8::gemm_phase<pg8::EpiMix<0>, pg8::StaticOrder, true, true>(ring, g, S, E);
#endif
        }
        GRID_BAR();
#ifndef NO_TOPK
        topk_phase_v1(F);
#endif
        GRID_BAR();
#ifndef NO_ATTN
        attn_phase_v1<false>(F, l);
        attn_phase_v1<true>(F, l);
#endif
#ifndef NO_POOL
        pool_phase(F);
#endif
        GRID_BAR();
        {
            pg8::Gemm g{CAT, (const bf16*)(wl + WL_OUT), T, DM, DM}; pg8::StaticOrder S; S.init(T, DM, F.G, (int)blockIdx.x);
            pg8::EpiRes E{F.out, XB, SSP, 1.0f};
            pg8::gemm_phase<pg8::EpiRes, pg8::StaticOrder, true, true>(ring, g, S, E);
        }
        GRID_BAR();
        {
            pg8::Gemm g{XB, (const bf16*)(wl + WL_2GU), T, NGU, DM}; pg8::StaticOrder S; S.init(T, NGU, F.G, (int)blockIdx.x);
            pg8::EpiGLU E{ACT, SSP, DFF};
            pg8::gemm_phase<pg8::EpiGLU, pg8::StaticOrder, true, true>(ring, g, S, E);
        }
        GRID_BAR();
        {
            pg8::Gemm g{ACT, (const bf16*)(wl + WL_2D), T, DM, DFF}; pg8::StaticOrder S; S.init(T, DM, F.G, (int)blockIdx.x);
            pg8::EpiRes E{F.out, XB, SSP, 0.5f};
            pg8::gemm_phase<pg8::EpiRes, pg8::StaticOrder, true, true>(ring, g, S, E);
        }
        if (l + 1 < DEPTH) GRID_BAR();
    }
}

extern "C" void kernel_launch(void* const* d_in, const int* in_sizes, int n_in, void* d_out, int out_size, void* d_ws, size_t ws_size, hipStream_t stream) {
    static int grid = 0;
    if (grid == 0) {
        if (n_in != 21 || out_size != T * DM || ws_size < WS_END) { fprintf(stderr, "kernel_launch: unexpected shapes (n_in %d, out %d, ws %zu)\n", n_in, out_size, ws_size); grid = -1; return; }
        int dev = 0, cus = 0, per_cu = 0;
        if (hipGetDevice(&dev) != hipSuccess || hipDeviceGetAttribute(&cus, hipDeviceAttributeMultiprocessorCount, dev) != hipSuccess) { grid = -1; return; }
        if (hipFuncSetAttribute((const void*)fwd_kernel, hipFuncAttributeMaxDynamicSharedMemorySize, LDS_BYTES) != hipSuccess) { fprintf(stderr, "kernel_launch: hipFuncSetAttribute failed\n"); grid = -1; return; }
        if (hipOccupancyMaxActiveBlocksPerMultiprocessor(&per_cu, (const void*)fwd_kernel, NWAVES * 64, LDS_BYTES) != hipSuccess || per_cu < 1) { fprintf(stderr, "kernel_launch: occupancy query says %d\n", per_cu); }
        (void)hipGetLastError();
        grid = cus;
    }
    if (grid < 0) return;
    if (hipMemsetAsync((char*)d_ws + WS_CTL, 0, CTL_ZERO_BYTES, stream) != hipSuccess) return;
    Args a{};
    for (int i = 0; i < 21; ++i) a.in[i] = (const float*)d_in[i];
    a.out = (float*)d_out; a.ws = (unsigned char*)d_ws;
    hipLaunchKernelGGL(fwd_kernel, dim3(grid), dim3(NWAVES * 64), LDS_BYTES, stream, a);
}
```

```cpp
#include <hip/hip_runtime.h>
#include <cstdio>
#include <cstdint>
namespace pg8 {
#define PG8_LAS __attribute__((address_space(3)))
typedef unsigned short bf16_t;
typedef short bf16x8 __attribute__((ext_vector_type(8)));
typedef float f32x4 __attribute__((ext_vector_type(4)));
typedef unsigned u32x4 __attribute__((ext_vector_type(4)));
constexpr int BM = 256, BK = 64, HALF = 128, HTB = HALF * BK * 2  , STAGE_BYTES = 8 * HTB, NXCD = 8, WGM = 8;

__host__ __device__ __forceinline__ int lds_byte(int r, int c) { const int st = (r >> 4) * 2 + (c >> 5), rr = r & 15, cc = c & 31, ob = rr * 64 + cc * 2; return st * 1024 + (ob ^ (((ob >> 9) & 1) << 5)); }
__host__ __device__ __forceinline__ void stage_rc(int b, int& R, int& C) { const int st = b / 1024, sb = b % 1024, swz = sb ^ (((sb >> 9) & 1) << 5); R = (st >> 1) * 16 + swz / 64; C = (st & 1) * 32 + (swz % 64) / 2; }
__host__ __device__ __forceinline__ int perm32(int rho) { const int n = rho >> 4, i = rho & 15; return 8 * (i >> 2) + 4 * n + (i & 3); }

struct Unit { int pm, pn; };
struct Gemm { const bf16_t* A; const bf16_t* Bt; int M, N, K; };

struct StaticOrder {
    int nM, nN, nwg, G, c;
    __host__ __device__ void init(int M, int N, int G_, int c_) { nM = M / BM; nN = N / BM; nwg = nM * nN; G = G_; c = c_; }
    __host__ __device__ bool next(int i, Unit& u) const {
        const long L = (long)i * G + c; if (L >= nwg) return false;
        int wgid = (int)L; { const int q = nwg / NXCD, r = nwg % NXCD, xcd = wgid % NXCD, off = wgid / NXCD; wgid = (xcd < r ? xcd * (q + 1) : r * (q + 1) + (xcd - r) * q) + off; }
        const int nig = WGM * nN, gid = wgid / nig, fm = gid * WGM, gsz = (nM - fm) < WGM ? (nM - fm) : WGM;
        u.pm = fm + ((wgid % nig) % gsz); u.pn = (wgid % nig) / gsz; return true;
    }
    __device__ __forceinline__ void a_ready(const Unit&) const {}
    __device__ __forceinline__ void done(const Unit&) const {}
};
__device__ __forceinline__ unsigned cvt_pk_bf16(float lo, float hi) { unsigned r; asm volatile("v_cvt_pk_bf16_f32 %0, %1, %2" : "=v"(r) : "v"(lo), "v"(hi)); return r; }
typedef int i32x4 __attribute__((ext_vector_type(4)));
template <class Epi, class Sched, bool ALIGN_EPI = false, bool SP2 = false, bool I8 = false>
__device__ __forceinline__ void gemm_phase(PG8_LAS unsigned char* lds, const Gemm g, const Sched& S, const Epi& E, int tid_in) {
    int tid_ = tid_in; asm volatile("" : "+v"(tid_));
    const int tid = tid_, wid = __builtin_amdgcn_readfirstlane(tid >> 6), lane = tid & 63, wr = wid >> 2, wc = wid & 3, fr = lane & 15, fq = lane >> 4;
    const int K = g.K, nt = K / BK;
    unsigned voffA[2], voffB[2];
#pragma unroll
    for (int i = 0; i < 2; ++i) { int R, C; stage_rc(tid * 16 + i * 8192, R, C); const int Rb = Epi::PERM ? ((R & ~31) + perm32(R & 31)) : R;
        voffA[i] = (unsigned)(R * K + C) * 2u; voffB[i] = (unsigned)(Rb * K + C) * 2u; }
    const size_t kstep = (size_t)(BK * 2);
    const size_t hstep = (size_t)HALF * K * 2;
    const size_t tstep = 2 * hstep;
    const unsigned ldsw = (unsigned)wid * 1024u;
    const int aoff = lds_byte(wr * 64 + fr, fq * 8), boff = lds_byte(wc * 32 + fr, fq * 8);
#define PG8_SA(b, h) (((b) * 2 + (h)) * HTB)
#define PG8_SB(b, h) ((4 + (b) * 2 + (h)) * HTB)
#define PG8_STAGE(bufoff, gbase, voff) do { _Pragma("unroll") for (int _i = 0; _i < 2; ++_i) \
        __builtin_amdgcn_global_load_lds((const unsigned*)((const char*)(gbase) + (voff)[_i]), (PG8_LAS unsigned*)(lds + (bufoff) + ldsw + _i * 8192), 16, 0, 0); } while (0)
#define PG8_LDA(dst, b, h) do { _Pragma("unroll") for (int m = 0; m < 4; ++m) _Pragma("unroll") for (int k = 0; k < 2; ++k) dst[m][k] = *(const PG8_LAS bf16x8*)(lds + PG8_SA(b, h) + aoff + m * 2048 + k * 1024); } while (0)
#define PG8_LDB(dst, b, h) do { _Pragma("unroll") for (int n = 0; n < 2; ++n) _Pragma("unroll") for (int k = 0; k < 2; ++k) dst[n][k] = *(const PG8_LAS bf16x8*)(lds + PG8_SB(b, h) + boff + n * 2048 + k * 1024); } while (0)
#define PG8_MMA(ai, bj, At, Bt) do { __builtin_amdgcn_s_setprio(1); _Pragma("unroll") for (int m = 0; m < 4; ++m) _Pragma("unroll") for (int n = 0; n < 2; ++n) _Pragma("unroll") for (int k = 0; k < 2; ++k) \
        { if constexpr (I8) acc[ai][bj][m][n] = __builtin_bit_cast(AccT, __builtin_amdgcn_mfma_i32_16x16x64_i8(__builtin_bit_cast(i32x4, Bt[n][k]), __builtin_bit_cast(i32x4, At[m][k]), __builtin_bit_cast(i32x4, acc[ai][bj][m][n]), 0, 0, 0)); \
          else acc[ai][bj][m][n] = __builtin_bit_cast(AccT, __builtin_amdgcn_mfma_f32_16x16x32_bf16(Bt[n][k], At[m][k], __builtin_bit_cast(f32x4, acc[ai][bj][m][n]), 0, 0, 0)); } __builtin_amdgcn_s_setprio(0); } while (0)
#define PG8_WAIT_V(n) asm volatile("s_waitcnt vmcnt(" #n ")" ::: "memory")
#define PG8_WAIT_L(n) asm volatile("s_waitcnt lgkmcnt(" #n ")" ::: "memory")
#define PG8_BAR __builtin_amdgcn_s_barrier()
#define PG8_SCHED __builtin_amdgcn_sched_barrier(0)
    Unit cur, nxt; int ui = 0;
    if (!S.next(0, cur)) return;
    typedef typename Epi::AccT AccT;
    AccT acc[2][2][4][2];
#pragma unroll
    for (int a = 0; a < 2; ++a)
#pragma unroll
        for (int b = 0; b < 2; ++b)
#pragma unroll
            for (int m = 0; m < 4; ++m)
#pragma unroll
                for (int n = 0; n < 2; ++n) acc[a][b][m][n] = AccT{};
    bf16x8 At[4][2], B0[2][2], B1[2][2];
    const char* cA = (const char*)g.A + (size_t)cur.pm * tstep; const char* cB = (const char*)g.Bt + (size_t)cur.pn * tstep;
    S.a_ready(cur);
    if constexpr (SP2) {
        PG8_STAGE(PG8_SB(0, 0), cB, voffB); PG8_STAGE(PG8_SB(0, 1), cB + hstep, voffB); PG8_STAGE(PG8_SA(0, 0), cA, voffA); PG8_STAGE(PG8_SA(0, 1), cA + hstep, voffA);
        if (wr == 1) PG8_BAR;
        PG8_WAIT_V(2); PG8_BAR;
        PG8_STAGE(PG8_SB(1, 0), cB + kstep, voffB); PG8_STAGE(PG8_SA(1, 0), cA + kstep, voffA); PG8_STAGE(PG8_SB(1, 1), cB + hstep + kstep, voffB);
        PG8_WAIT_V(6); PG8_BAR;
    } else {
        PG8_STAGE(PG8_SB(0, 0), cB, voffB); PG8_STAGE(PG8_SA(0, 0), cA, voffA); PG8_STAGE(PG8_SB(0, 1), cB + hstep, voffB); PG8_STAGE(PG8_SA(0, 1), cA + hstep, voffA);
        if (wr == 1) PG8_BAR;
        PG8_WAIT_V(4); PG8_BAR;
        PG8_STAGE(PG8_SB(1, 0), cB + kstep, voffB); PG8_STAGE(PG8_SA(1, 0), cA + kstep, voffA); PG8_STAGE(PG8_SB(1, 1), cB + hstep + kstep, voffB);
        PG8_WAIT_V(6); PG8_BAR;
    }
    for (;;) {
        const bool has_next = S.next(ui + 1, nxt);
        const char* nA = has_next ? (const char*)g.A + (size_t)nxt.pm * tstep : cA; const char* nB = has_next ? (const char*)g.Bt + (size_t)nxt.pn * tstep : cB;
        for (int t = 0; t < nt; t += 2) {
            const bool last = (t == nt - 2);
            const char* a1 = cA + (size_t)(t + 1) * kstep;
            const char* a2 = last ? nA : cA + (size_t)(t + 2) * kstep; const char* b2 = last ? nB : cB + (size_t)(t + 2) * kstep;
            const char* a3 = a2 + kstep; const char* b3 = b2 + kstep;
            if (last && has_next) S.a_ready(nxt);
            if constexpr (SP2) {
            PG8_LDB(B0, 0, 0); PG8_LDB(B1, 0, 1); PG8_SCHED; PG8_LDA(At, 0, 0); PG8_STAGE(PG8_SA(1, 1), a1 + hstep, voffA);
            PG8_WAIT_V(8); PG8_WAIT_L(0); PG8_BAR; PG8_MMA(0, 0, At, B0); PG8_MMA(0, 1, At, B1); PG8_BAR; PG8_SCHED;
            PG8_LDA(At, 0, 1); PG8_STAGE(PG8_SB(0, 0), b2, voffB); PG8_STAGE(PG8_SB(0, 1), b2 + hstep, voffB); PG8_STAGE(PG8_SA(0, 0), a2, voffA);
            PG8_WAIT_V(8); PG8_WAIT_L(0); PG8_BAR; PG8_MMA(1, 0, At, B0); PG8_MMA(1, 1, At, B1); PG8_BAR; PG8_SCHED;
            PG8_LDB(B0, 1, 0); PG8_LDB(B1, 1, 1); PG8_SCHED; PG8_LDA(At, 1, 0); PG8_STAGE(PG8_SA(0, 1), a2 + hstep, voffA);
            PG8_WAIT_V(8); PG8_WAIT_L(0); PG8_BAR; PG8_MMA(0, 0, At, B0); PG8_MMA(0, 1, At, B1); PG8_BAR; PG8_SCHED;
            PG8_LDA(At, 1, 1); PG8_STAGE(PG8_SB(1, 0), b3, voffB); PG8_STAGE(PG8_SB(1, 1), b3 + hstep, voffB); PG8_STAGE(PG8_SA(1, 0), a3, voffA);
            PG8_WAIT_V(8); PG8_WAIT_L(0); PG8_BAR; PG8_MMA(1, 0, At, B0); PG8_MMA(1, 1, At, B1); PG8_BAR; PG8_SCHED;
            } else {
            PG8_LDB(B0, 0, 0); PG8_SCHED; PG8_LDA(At, 0, 0); PG8_STAGE(PG8_SA(1, 1), a1 + hstep, voffA);
            PG8_WAIT_L(8); PG8_BAR; PG8_WAIT_L(0); PG8_MMA(0, 0, At, B0); PG8_BAR; PG8_SCHED;
            PG8_LDB(B1, 0, 1); PG8_STAGE(PG8_SB(0, 0), b2, voffB);
            PG8_BAR; PG8_WAIT_L(0); PG8_MMA(0, 1, At, B1); PG8_BAR;
            PG8_LDA(At, 0, 1); PG8_STAGE(PG8_SA(0, 0), a2, voffA);
            PG8_BAR; PG8_WAIT_L(0); PG8_MMA(1, 0, At, B0); PG8_BAR; PG8_SCHED;
            PG8_STAGE(PG8_SB(0, 1), b2 + hstep, voffB);
            PG8_WAIT_V(6); PG8_BAR; PG8_MMA(1, 1, At, B1); PG8_BAR;
            PG8_LDB(B0, 1, 0); PG8_SCHED; PG8_LDA(At, 1, 0); PG8_STAGE(PG8_SA(0, 1), a2 + hstep, voffA);
            PG8_WAIT_L(8); PG8_BAR; PG8_WAIT_L(0); PG8_MMA(0, 0, At, B0); PG8_BAR; PG8_SCHED;
            PG8_LDB(B1, 1, 1); PG8_STAGE(PG8_SB(1, 0), b3, voffB);
            PG8_BAR; PG8_WAIT_L(0); PG8_MMA(0, 1, At, B1); PG8_BAR;
            PG8_LDA(At, 1, 1); PG8_STAGE(PG8_SA(1, 0), a3, voffA);
            PG8_BAR; PG8_WAIT_L(0); PG8_MMA(1, 0, At, B0); PG8_BAR; PG8_SCHED;
            PG8_STAGE(PG8_SB(1, 1), b3 + hstep, voffB);
            PG8_WAIT_V(6); PG8_BAR; PG8_MMA(1, 1, At, B1); PG8_BAR;
            }
        }
        if constexpr (ALIGN_EPI) { if (wr == 0) PG8_BAR; }
        if constexpr (!Epi::AFTER_DRAIN) { E(acc, cur, wr, wc, fr, fq); S.done(cur); }
        if (!has_next) break;
#pragma unroll
        for (int a = 0; a < 2; ++a)
#pragma unroll
            for (int b = 0; b < 2; ++b)
#pragma unroll
                for (int m = 0; m < 4; ++m)
#pragma unroll
                    for (int n = 0; n < 2; ++n) acc[a][b][m][n] = AccT{};
        cur = nxt; cA = nA; cB = nB; ++ui;
        if constexpr (ALIGN_EPI) { if (wr == 1) PG8_BAR; }
    }
    PG8_WAIT_V(0);
    if constexpr (!ALIGN_EPI) { if (wr == 0) PG8_BAR; }
    PG8_BAR;
    if constexpr (Epi::AFTER_DRAIN) { E.fused(acc, cur, wr, wc, fr, fq, lds, wid, lane); S.done(cur); }
#undef PG8_SA
#undef PG8_SB
#undef PG8_STAGE
#undef PG8_LDA
#undef PG8_LDB
#undef PG8_MMA
#undef PG8_WAIT_V
#undef PG8_WAIT_L
#undef PG8_BAR
#undef PG8_SCHED
}
}
namespace pg8 {
constexpr float NORM_EPS = 1e-6f;
typedef unsigned long long u64_t;
constexpr float SS_FIX = 1048576.0f;
__device__ __forceinline__ float ss_val(u64_t v) { return (float)v * (1.0f / SS_FIX); }
__device__ __forceinline__ float row_rstd(const float* ss, int row) { return __builtin_amdgcn_rsqf(ss[row] * (1.0f / 1024.0f) + NORM_EPS); }
__device__ __forceinline__ float silu_mul(float g, float u) { return g * __builtin_amdgcn_rcpf(1.0f + __builtin_amdgcn_exp2f(-1.4426950408889634f * g)) * u; }

struct EpiGLU8 {
    typedef i32x4 AccT;
    static constexpr bool PERM = true, AFTER_DRAIN = false;
    bf16_t* act; const float* ssp; const float* sx; const float* sw; int ldc;
    __device__ __forceinline__ void operator()(const i32x4 (&acc)[2][2][4][2], const Unit& u, int wr, int wc, int fr, int fq) const {
        const int row0 = u.pm * BM + wr * 64 + fr, col0 = u.pn * 128 + wc * 32 + 8 * fq;
        const float* swp = sw + u.pn * 256 + wc * 32 + 8 * fq;
        const f32x4 sg0 = *(const f32x4*)swp, sg1 = *(const f32x4*)(swp + 4), su0 = *(const f32x4*)(swp + 128), su1 = *(const f32x4*)(swp + 132);
        const f32x4 sl0 = sg0 * -1.4426950408889634f, sl1 = sg1 * -1.4426950408889634f, sp0 = sg0 * su0, sp1 = sg1 * su1;
        float rsv[2][4];
#pragma unroll
        for (int ai = 0; ai < 2; ++ai)
#pragma unroll
            for (int m = 0; m < 4; ++m) rsv[ai][m] = sx[row0 + ai * HALF + m * 16];
#pragma unroll
        for (int ai = 0; ai < 2; ++ai)
#pragma unroll
            for (int m = 0; m < 4; ++m) { const int row = row0 + ai * HALF + m * 16; const float rs = rsv[ai][m];
                const f32x4 rr = {rs, rs, rs, rs};
                f32x4 a0, a1, b0, b1;
#pragma unroll
                for (int e = 0; e < 4; ++e) { a0[e] = (float)acc[ai][0][m][0][e]; a1[e] = (float)acc[ai][0][m][1][e]; b0[e] = (float)acc[ai][1][m][0][e]; b1[e] = (float)acc[ai][1][m][1][e]; }
                a0 = a0 * rr; a1 = a1 * rr; b0 = b0 * rr; b1 = b1 * rr;
                const f32x4 t0 = a0 * sl0, t1 = a1 * sl1;
                f32x4 d0, d1;
#pragma unroll
                for (int e = 0; e < 4; ++e) { d0[e] = __builtin_amdgcn_exp2f(t0[e]); d1[e] = __builtin_amdgcn_exp2f(t1[e]); }
                d0 = d0 + 1.0f; d1 = d1 + 1.0f;
#pragma unroll
                for (int e = 0; e < 4; ++e) { d0[e] = __builtin_amdgcn_rcpf(d0[e]); d1[e] = __builtin_amdgcn_rcpf(d1[e]); }
                const f32x4 h0 = (a0 * b0) * (sp0 * d0), h1 = (a1 * b1) * (sp1 * d1);
                u32x4 w; w.x = cvt_pk_bf16(h0[0], h0[1]); w.y = cvt_pk_bf16(h0[2], h0[3]); w.z = cvt_pk_bf16(h1[0], h1[1]); w.w = cvt_pk_bf16(h1[2], h1[3]);
                *(u32x4*)(act + (size_t)row * ldc + col0) = w; asm volatile("" ::: "memory"); }
    }
};
struct EpiRes {
    typedef f32x4 AccT;
    static constexpr bool PERM = true, AFTER_DRAIN = false;
    float* xout; bf16_t* xb; u64_t* ssn; float alpha;
    __device__ __forceinline__ void operator()(const f32x4 (&acc)[2][2][4][2], const Unit& u, int wr, int wc, int fr, int fq) const {
        const int row0 = u.pm * BM + wr * 64 + fr, col0 = u.pn * BM + wc * 32 + 8 * fq;
#pragma unroll
        for (int ai = 0; ai < 2; ++ai) {
            u32x4 xo[4][2];
#pragma unroll
            for (int m = 0; m < 4; ++m)
#pragma unroll
                for (int bj = 0; bj < 2; ++bj) xo[m][bj] = *(const u32x4*)(xb + (size_t)(row0 + ai * HALF + m * 16) * 1024 + col0 + bj * HALF);
#pragma unroll
            for (int m = 0; m < 4; ++m) { const int row = row0 + ai * HALF + m * 16; float q = 0.f;
#pragma unroll
                for (int bj = 0; bj < 2; ++bj) { const u32x4 xw = xo[m][bj];
                    f32x4 a, b;
                    a[0] = __builtin_bit_cast(float, xw.x << 16); a[1] = __builtin_bit_cast(float, xw.x & 0xffff0000u); a[2] = __builtin_bit_cast(float, xw.y << 16); a[3] = __builtin_bit_cast(float, xw.y & 0xffff0000u);
                    b[0] = __builtin_bit_cast(float, xw.z << 16); b[1] = __builtin_bit_cast(float, xw.z & 0xffff0000u); b[2] = __builtin_bit_cast(float, xw.w << 16); b[3] = __builtin_bit_cast(float, xw.w & 0xffff0000u);
                    a = a + acc[ai][bj][m][0] * alpha; b = b + acc[ai][bj][m][1] * alpha;
                    if (xout) { float* p = xout + (size_t)row * 1024 + col0 + bj * HALF; *(f32x4*)p = a; *(f32x4*)(p + 4) = b; }
                    u32x4 w; w.x = cvt_pk_bf16(a[0], a[1]); w.y = cvt_pk_bf16(a[2], a[3]); w.z = cvt_pk_bf16(b[0], b[1]); w.w = cvt_pk_bf16(b[2], b[3]);
                    const float r0 = __builtin_bit_cast(float, w.x << 16), r1 = __builtin_bit_cast(float, w.x & 0xffff0000u), r2 = __builtin_bit_cast(float, w.y << 16), r3 = __builtin_bit_cast(float, w.y & 0xffff0000u);
                    const float r4 = __builtin_bit_cast(float, w.z << 16), r5 = __builtin_bit_cast(float, w.z & 0xffff0000u), r6 = __builtin_bit_cast(float, w.w << 16), r7 = __builtin_bit_cast(float, w.w & 0xffff0000u);
                    q += ((r0 * r0 + r1 * r1) + (r2 * r2 + r3 * r3)) + ((r4 * r4 + r5 * r5) + (r6 * r6 + r7 * r7));
                    *(u32x4*)(xb + (size_t)row * 1024 + col0 + bj * HALF) = w; }
                q += __shfl_xor(q, 16); q += __shfl_xor(q, 32);
                if (fq == 0) __hip_atomic_fetch_add(ssn + row, (u64_t)(q * SS_FIX), __ATOMIC_RELAXED, __HIP_MEMORY_SCOPE_AGENT); }
            asm volatile("" ::: "memory"); }
    }
};
template <int MODE> struct EpiMix {
    typedef f32x4 AccT;
    static constexpr bool PERM = true, AFTER_DRAIN = false;
    const void* ssp;
    bf16_t *aq, *ak, *av, *iq, *pu, *mq, *ik; float* iw;
    const float *gq, *gk, *gmq;
    float c2;
    __device__ __forceinline__ void operator()(const f32x4 (&acc)[2][2][4][2], const Unit& u, int wr, int wc, int fr, int fq) const {
        const int row0 = u.pm * BM + wr * 64 + fr, pn = u.pn;
        if (MODE == 0) __builtin_amdgcn_s_setreg(1 | (23 << 6), 1);
        bf16_t* base; int pitch, kind; const float* g = gk; float sc = 1.0f;
        if (MODE == 1) { const int layer = pn >> 1; kind = pn & 1; base = ((pn & 1) ? av : aq) + (size_t)layer * 512 * 256; pitch = 256; g = gk + layer * 64; }
        else if (pn < 2) { base = aq + pn * 128; pitch = 256; kind = 0; g = gq; sc = __builtin_sqrtf(c2); }
        else if (pn < 4) { base = ak + (pn - 2) * 128; pitch = 256; kind = 0; g = gk; sc = __builtin_sqrtf(c2); }
        else if (pn < 6) { base = av + (pn - 4) * 256; pitch = 512; kind = 1; }
        else if (pn == 6) { base = iq; pitch = 256; kind = 2; }
        else if (pn == 7) { base = pu; pitch = 256; kind = 2; }
        else if (pn == 8) { base = mq; pitch = 256; kind = 0; g = gmq; sc = c2; }
        else { base = ik; pitch = 64; kind = 3; }
        const int co0 = (kind == 2) ? wc * 32 + 8 * fq : wc * 64 + 8 * fq, co1 = (kind == 2) ? co0 + HALF : co0 + 32;
        float ssv[2][4];
#pragma unroll
        for (int ai = 0; ai < 2; ++ai)
#pragma unroll
            for (int m = 0; m < 4; ++m) { const int rr = row0 + ai * HALF + m * 16; ssv[ai][m] = (MODE == 1) ? ((const float*)ssp)[rr] : ss_val(((const u64_t*)ssp)[rr]); }
        f32x4 gv[2][2];
#pragma unroll
        for (int bj = 0; bj < 2; ++bj)
#pragma unroll
            for (int n = 0; n < 2; ++n) gv[bj][n] = (kind == 0) ? *(const f32x4*)(g + bj * 32 + 8 * fq + 4 * n) * sc : (f32x4){1.f, 1.f, 1.f, 1.f};
#pragma unroll
        for (int ai = 0; ai < 2; ++ai)
#pragma unroll
            for (int m = 0; m < 4; ++m) { const int row = row0 + ai * HALF + m * 16; const float rs = __builtin_amdgcn_rsqf(ssv[ai][m] * (1.0f / 1024.0f) + NORM_EPS);
                if (kind == 3) {
                    if (wc < 2) { const f32x4 a = acc[ai][0][m][0] * rs, b = acc[ai][0][m][1] * rs;
                        u32x4 w; w.x = cvt_pk_bf16(a[0], a[1]); w.y = cvt_pk_bf16(a[2], a[3]); w.z = cvt_pk_bf16(b[0], b[1]); w.w = cvt_pk_bf16(b[2], b[3]);
                        *(u32x4*)(base + (size_t)row * 64 + wc * 32 + 8 * fq) = w; }
                    else if (wc == 2 && fq == 0) { *(f32x4*)(iw + (size_t)row * 4) = acc[ai][0][m][0] * rs; }
                } else {
                    f32x4 v[2][2];
#pragma unroll
                    for (int bj = 0; bj < 2; ++bj)
#pragma unroll
                        for (int n = 0; n < 2; ++n) v[bj][n] = acc[ai][bj][m][n] * rs;
                    float r = 1.0f;
                    if (kind == 0) { float s = 0.f;
#pragma unroll
                        for (int bj = 0; bj < 2; ++bj)
#pragma unroll
                            for (int n = 0; n < 2; ++n) s += (v[bj][n][0] * v[bj][n][0] + v[bj][n][1] * v[bj][n][1]) + (v[bj][n][2] * v[bj][n][2] + v[bj][n][3] * v[bj][n][3]);
                        s += __shfl_xor(s, 16); s += __shfl_xor(s, 32);
                        r = __builtin_amdgcn_rsqf(s * (1.0f / 64.0f) + NORM_EPS); }
                    bf16_t* rp = base + (size_t)row * pitch;
                    unsigned char* vt = (unsigned char*)av + ((size_t)((row >> 14) * 8 + (pn - 4) * 4 + wc) * 64 + 8 * fq) * 16384 + (row & 16383);
#pragma unroll
                    for (int bj = 0; bj < 2; ++bj) { const f32x4 a = v[bj][0] * gv[bj][0] * r, b = v[bj][1] * gv[bj][1] * r;
                        u32x4 w; w.x = cvt_pk_bf16(a[0], a[1]); w.y = cvt_pk_bf16(a[2], a[3]); w.z = cvt_pk_bf16(b[0], b[1]); w.w = cvt_pk_bf16(b[2], b[3]);
                        if (MODE == 0 && pn < 4) {
                            int p0 = __builtin_amdgcn_cvt_pk_fp8_f32(a[0], a[1], 0, false); p0 = __builtin_amdgcn_cvt_pk_fp8_f32(a[2], a[3], p0, true);
                            int p1 = __builtin_amdgcn_cvt_pk_fp8_f32(b[0], b[1], 0, false); p1 = __builtin_amdgcn_cvt_pk_fp8_f32(b[2], b[3], p1, true);
                            typedef unsigned u32x2_ __attribute__((ext_vector_type(2)));
                            *(u32x2_*)((unsigned char*)rp + wc * 64 + 32 * bj + 8 * fq) = (u32x2_){(unsigned)p0, (unsigned)p1}; }
                        else if (MODE == 0 && kind == 1) { unsigned char* vp = vt + (size_t)(32 * bj) * 16384;
                            int p0 = __builtin_amdgcn_cvt_pk_fp8_f32(a[0], a[1], 0, false); p0 = __builtin_amdgcn_cvt_pk_fp8_f32(a[2], a[3], p0, true);
                            int p1 = __builtin_amdgcn_cvt_pk_fp8_f32(b[0], b[1], 0, false); p1 = __builtin_amdgcn_cvt_pk_fp8_f32(b[2], b[3], p1, true);
                            vp[0 * 16384] = (unsigned char)p0; vp[1 * 16384] = (unsigned char)(p0 >> 8); vp[2 * 16384] = (unsigned char)(p0 >> 16); vp[3 * 16384] = (unsigned char)(p0 >> 24);
                            vp[4 * 16384] = (unsigned char)p1; vp[5 * 16384] = (unsigned char)(p1 >> 8); vp[6 * 16384] = (unsigned char)(p1 >> 16); vp[7 * 16384] = (unsigned char)(p1 >> 24); }
                        else *(u32x4*)(rp + (bj ? co1 : co0)) = w; }
                }
                asm volatile("" ::: "memory");
            }
    }
};
}
constexpr int NWAVES = 8;
constexpr int BATCH = 2, SEQ = 16384, DM = 1024, DEPTH = 4, T = BATCH * SEQ;
constexpr int DFF = 2816, NGU = 2 * DFF, DIN = 2372, NIN = 2560, NMEM = 256, NSEL = 256;
constexpr float C2 = 0.125f * 1.4426950408889634f;
constexpr size_t MiB = 1u << 20;
constexpr size_t WS_CTL = 0, CTL_ZERO_BYTES = 4 * MiB + 512 * 1024;
constexpr size_t WS_SSP = 1 * MiB;
constexpr size_t WS_SSM = 4 * MiB + 512 * 1024;
constexpr size_t WS_GN = 4 * MiB + 512 * 1024 + 48 * 1024;
constexpr size_t WS_MEMB = 4 * MiB + 512 * 1024 + 64 * 1024;
constexpr size_t WS_WKV = 6 * MiB;
constexpr size_t WS_MEMK = 10 * MiB, WS_MEMV = 11 * MiB;
constexpr size_t WS_SW = 5 * MiB + 768 * 1024;
constexpr size_t WS_TKQ = 128 * 1024;
constexpr size_t WS_CMX = 256 * 1024;
constexpr size_t WS_W = 12 * MiB;
constexpr size_t WL_1GU = 0, WL_1D = 11 * MiB, WL_IN = 11 * MiB + 5632 * 1024, WL_OUT = WL_IN + 5 * MiB, WL_2GU = WL_OUT + 2 * MiB, WL_2D = WL_2GU + 11 * MiB, WL_STRIDE = 40 * MiB;
static_assert(WL_2D + (size_t)DM * DFF * 2 <= WL_STRIDE, "layer weights");
constexpr size_t WS_XB = 172 * MiB;
constexpr size_t WS_CAT = 236 * MiB;
constexpr size_t WS_XQ = WS_CAT, WS_SX = WS_CAT + 32 * MiB;
constexpr size_t WS_ACT = 300 * MiB;
constexpr size_t WS_AQ = WS_ACT, WS_AK = WS_AQ + 32 * MiB, WS_AV = WS_AK + 32 * MiB, WS_IQ = WS_AV + 32 * MiB, WS_PU = WS_IQ + 16 * MiB, WS_MQ = WS_PU + 16 * MiB, WS_IK = WS_MQ + 16 * MiB, WS_IW = WS_IK + 4 * MiB;
constexpr size_t WS_END = WS_ACT + 176 * MiB;
static_assert(WS_IW + (size_t)T * 16 <= WS_END && WS_END <= 512 * MiB, "d_ws map");
constexpr int CW_BAR = 4096;
constexpr int RING_OFF = 0, RING_BYTES = 131072;
constexpr int LDSCTL_OFF = RING_BYTES, MISC_OFF = LDSCTL_OFF + 320;
constexpr int LDS_BYTES = 147456;
static_assert(MISC_OFF + 128 <= LDS_BYTES, "LDS map");
#define GAS __attribute__((address_space(1)))
#define LAS __attribute__((address_space(3)))
typedef unsigned short bf16;
typedef unsigned v4u __attribute__((ext_vector_type(4)));
typedef float f32x4 __attribute__((ext_vector_type(4)));
typedef short bf16x8 __attribute__((ext_vector_type(8)));
typedef GAS unsigned gu32;
typedef GAS unsigned long long gu64;
#define RLX_AGENT __ATOMIC_RELAXED, __HIP_MEMORY_SCOPE_AGENT
#define LDS_WAIT() asm volatile("s_waitcnt lgkmcnt(0)" ::: "memory")
#define VM_WAIT() asm volatile("s_waitcnt vmcnt(0)" ::: "memory")
__device__ __forceinline__ unsigned long long rt() { return __builtin_amdgcn_s_memrealtime(); }
__device__ __forceinline__ unsigned f2bf(float f) { unsigned u = __builtin_bit_cast(unsigned, f); return (u + 0x7fffu + ((u >> 16) & 1u)) >> 16; }
__device__ __forceinline__ unsigned pk2(float lo, float hi) { return f2bf(lo) | (f2bf(hi) << 16); }

#define XB_TMO      128
#define XB_XCNT(j)  (256  + 64 * (j))
#define XB_XSUB(j)  (1280 + 64 * (j))
#define XB_XGEN(j)  (2304 + 64 * (j))
#define XB_TOP      3328
#define XB_TOPGEN   3392
#define XCD_BAR_WORDS 3456
#define XB_SPIN_CAP (1u << 18)

__device__ __forceinline__ unsigned xb_ld(unsigned* p)              { return __hip_atomic_load(p, __ATOMIC_RELAXED, __HIP_MEMORY_SCOPE_AGENT); }
__device__ __forceinline__ unsigned xb_add(unsigned* p, unsigned v) { return __hip_atomic_fetch_add(p, v, __ATOMIC_RELAXED, __HIP_MEMORY_SCOPE_AGENT); }
__device__ __forceinline__ unsigned xb_xcc_id() { return (unsigned)__builtin_amdgcn_s_getreg((3 << 11) | 20) & 0xFu; }
#define XB_SPIN(cond, bar) do { unsigned _sp = 0; while (cond) { __builtin_amdgcn_s_sleep(1); \
    if ((++_sp & 255u) == 0u) { if (xb_ld(&(bar)[XB_TMO])) break; if (_sp > XB_SPIN_CAP) { atomicAdd(&(bar)[XB_TMO], 1u); break; } } } } while (0)

struct XcdBarrier {
    unsigned* bar; unsigned x;
    volatile LAS unsigned* st;
};

__device__ __forceinline__ XcdBarrier xcd_barrier_post(unsigned* bar, volatile LAS unsigned* st, int tid) {
    XcdBarrier b; b.bar = bar; b.x = xb_xcc_id(); b.st = st;
    if (tid == 0) (void)xb_add(&bar[XB_XCNT(b.x)], 1u);
    return b;
}
__device__ __forceinline__ void xcd_barrier_complete(unsigned* bar, unsigned x, unsigned& nloc, unsigned& nx) {
    const unsigned G = gridDim.x * gridDim.y * gridDim.z;
    unsigned sum, cnt, mine, sp = 0u;
    for (;;) {
        sum = 0u; cnt = 0u; mine = 0u;
#pragma unroll
        for (unsigned j = 0; j < 16; ++j) { const unsigned c = xb_ld(&bar[XB_XCNT(j)]); sum += c; cnt += (c > 0u) ? 1u : 0u; mine = (j == x) ? c : mine; }
        if (sum == G) break;
        __builtin_amdgcn_s_sleep(1);
        if ((++sp & 255u) == 0u) { if (xb_ld(&bar[XB_TMO])) break; if (sp > XB_SPIN_CAP) { atomicAdd(&bar[XB_TMO], 1u); break; } }
    }
    nloc = mine > 0u ? mine : 1u; nx = cnt > 0u ? cnt : 1u;
}

__device__ __forceinline__ void xcd_barrier(const XcdBarrier& b, int tid) {
    asm volatile("s_waitcnt vmcnt(0)" ::: "memory");
    __syncthreads();
    if (tid == 0) {
        unsigned* bar = b.bar; asm volatile("" : "+s"(bar));
        __builtin_amdgcn_s_waitcnt(0);
        unsigned nloc = b.st[0], nx = b.st[1];
        if (nloc == 0u) { xcd_barrier_complete(bar, b.x, nloc, nx); b.st[0] = nloc; b.st[1] = nx; }
        const unsigned old = xb_add(&bar[XB_XSUB(b.x)], 1u);
        const unsigned gen = old / nloc;
        if (old + 1u == (gen + 1u) * nloc) {
            __builtin_amdgcn_fence(__ATOMIC_RELEASE, "agent");
            asm volatile("s_waitcnt vmcnt(0)" ::: "memory");
            const unsigned og = xb_add(&bar[XB_TOP], 1u);
            const unsigned tg = og / nx;
            if (og + 1u == (tg + 1u) * nx) xb_add(&bar[XB_TOPGEN], 1u);
            else XB_SPIN(xb_ld(&bar[XB_TOPGEN]) == tg, bar);
            __builtin_amdgcn_fence(__ATOMIC_ACQUIRE, "agent");
            xb_add(&bar[XB_XGEN(b.x)], 1u);
            asm volatile("s_waitcnt vmcnt(0)" ::: "memory");
        } else {
            XB_SPIN(xb_ld(&bar[XB_XGEN(b.x)]) == gen, bar);
            __builtin_amdgcn_fence(__ATOMIC_ACQUIRE, "agent");
            asm volatile("s_waitcnt vmcnt(0)" ::: "memory");
        }
    }
    __syncthreads();
}

struct Args { const float* in[21]; float* out; unsigned char* ws; };
struct Frame {
    LAS unsigned char* lds;
    volatile LAS unsigned* MISC;
    gu32* ctl;
    int tid, lane, wave, G;
    unsigned char* ws;
    float* out;
};
__device__ __forceinline__ int lane_id_now() { unsigned z = 0u; asm volatile("" : "+v"(z)); return (int)__builtin_amdgcn_mbcnt_hi(~0u, __builtin_amdgcn_mbcnt_lo(~0u, z)); }
__device__ __forceinline__ float bf2f(unsigned b) { return __builtin_bit_cast(float, b << 16); }
__device__ __forceinline__ float bflo(unsigned w) { return __builtin_bit_cast(float, w << 16); }
__device__ __forceinline__ float bfhi(unsigned w) { return __builtin_bit_cast(float, w & 0xffff0000u); }
__device__ __forceinline__ float wave_sum(float v) {
#pragma unroll
    for (int o = 1; o < 64; o <<= 1) v += __shfl_xor(v, o);
    return v;
}
template <class RowMap>
__device__ __forceinline__ void tr_item(const float* W, int K, int N, const float* gain, bf16* WT, RowMap rm, LAS float* scr, int item, int lane) {
    const int nblk = (N + 31) / 32, kb = item / nblk, nb = item % nblk, k0 = 64 * kb, n0 = 32 * nb;
    const int nn = n0 + (lane & 31);
    float tv[32];
#pragma unroll
    for (int i = 0; i < 32; ++i) { const int kk = 2 * i + (lane >> 5); tv[i] = (nn < N) ? W[(size_t)(k0 + kk) * N + nn] : 0.f; }
    if (gain) {
#pragma unroll
        for (int i = 0; i < 32; ++i) tv[i] *= gain[k0 + 2 * i + (lane >> 5)]; }
#pragma unroll
    for (int i = 0; i < 32; ++i) scr[(2 * i + (lane >> 5)) * 33 + (lane & 31)] = tv[i];
    LDS_WAIT(); asm volatile("" ::: "memory");
    const int c = lane & 7;
#pragma unroll
    for (int j = 0; j < 4; ++j) { const int n = (lane >> 3) + 8 * j; const LAS float* s = scr + (8 * c) * 33 + n;
        v4u o; o.x = pk2(s[0 * 33], s[1 * 33]); o.y = pk2(s[2 * 33], s[3 * 33]); o.z = pk2(s[4 * 33], s[5 * 33]); o.w = pk2(s[6 * 33], s[7 * 33]);
        if (n0 + n < N) *(GAS v4u*)(WT + (size_t)rm(n0 + n) * K + k0 + 8 * c) = o; }
    LDS_WAIT(); asm volatile("" ::: "memory");
}
__device__ __forceinline__ void tr_item_pool(const float* Wout, const float* wpool  , const float* pscale  , bf16* WT, LAS float* scr, int g, int nb, int lane) {
    const int k0 = 512 + 64 * g, n0 = 32 * nb;
#pragma unroll 8
    for (int i = 0; i < 32; ++i) { const int kk = 2 * i + (lane >> 5); scr[kk * 33 + (lane & 31)] = Wout[(size_t)(k0 + kk) * 1024 + n0 + (lane & 31)] * pscale[64 * g + kk]; }
    LDS_WAIT(); asm volatile("" ::: "memory");
    float o[32];
    const int nl = lane & 31;
#pragma unroll
    for (int i = 0; i < 32; ++i) { const float* wr_ = wpool + (size_t)(g * 64 + 2 * i + (lane >> 5)) * 64; float a = 0.f;
        for (int d4 = 0; d4 < 16; ++d4) { const f32x4 w = *(const f32x4*)(wr_ + 4 * d4);
            a += (w[0] * scr[(4 * d4) * 33 + nl] + w[1] * scr[(4 * d4 + 1) * 33 + nl]) + (w[2] * scr[(4 * d4 + 2) * 33 + nl] + w[3] * scr[(4 * d4 + 3) * 33 + nl]); }
        o[i] = a; }
    LDS_WAIT(); asm volatile("" ::: "memory");
#pragma unroll
    for (int i = 0; i < 32; ++i) scr[(2 * i + (lane >> 5)) * 33 + (lane & 31)] = o[i];
    LDS_WAIT(); asm volatile("" ::: "memory");
    const int c = lane & 7;
#pragma unroll
    for (int j = 0; j < 4; ++j) { const int n = (lane >> 3) + 8 * j; const LAS float* s = scr + (8 * c) * 33 + n;
        v4u o2; o2.x = pk2(s[0 * 33], s[1 * 33]); o2.y = pk2(s[2 * 33], s[3 * 33]); o2.z = pk2(s[4 * 33], s[5 * 33]); o2.w = pk2(s[6 * 33], s[7 * 33]);
        *(GAS v4u*)(WT + (size_t)(n0 + n) * 1024 + k0 + 8 * c) = o2; }
    LDS_WAIT(); asm volatile("" ::: "memory");
}
template <class RowMap>
__device__ __forceinline__ void cmax_item(const float* W, int K, int N, const float* gain, unsigned* cmx, RowMap rm, int item, int lane) {
    const int nblk = (N + 31) / 32, kb = item / nblk, nb = item % nblk, k0 = 64 * kb, n0 = 32 * nb; const int nn = n0 + (lane & 31);
    float tv[32];
#pragma unroll
    for (int i = 0; i < 32; ++i) { const int kk = 2 * i + (lane >> 5); tv[i] = (nn < N) ? W[(size_t)(k0 + kk) * N + nn] : 0.f; }
    float mx = 0.f;
#pragma unroll
    for (int i = 0; i < 32; ++i) mx = fmaxf(mx, fabsf(tv[i] * gain[k0 + 2 * i + (lane >> 5)]));
    mx = fmaxf(mx, __shfl_xor(mx, 32));
    if (lane < 32 && nn < N) atomicMax(cmx + rm(nn), __builtin_bit_cast(unsigned, mx));
}
template <class RowMap>
__device__ __forceinline__ void q8_item(const float* W, int K, int N, const float* gain, signed char* W8, const unsigned* cmx, float* sw, RowMap rm, LAS float* scr, int item, int lane) {
    const int nblk = (N + 31) / 32, kb = item / nblk, nb = item % nblk, k0 = 64 * kb, n0 = 32 * nb; const int nn = n0 + (lane & 31);
    float tv[32];
#pragma unroll
    for (int i = 0; i < 32; ++i) { const int kk = 2 * i + (lane >> 5); tv[i] = (nn < N) ? W[(size_t)(k0 + kk) * N + nn] : 0.f; }
    const float cm = (nn < N) ? __builtin_bit_cast(float, cmx[rm(nn)]) : 0.f;
    const float inv = cm > 0.f ? 127.0f / cm : 0.f;
    if (kb == 0 && lane < 32 && nn < N) sw[rm(nn)] = cm * (1.0f / 127.0f);
#pragma unroll
    for (int i = 0; i < 32; ++i) scr[(2 * i + (lane >> 5)) * 33 + (lane & 31)] = __builtin_rintf(tv[i] * gain[k0 + 2 * i + (lane >> 5)] * inv);
    LDS_WAIT(); asm volatile("" ::: "memory");
    const int n = lane >> 1, hf = lane & 1; const LAS float* s = scr + (32 * hf) * 33 + n;
    unsigned pk[8];
#pragma unroll
    for (int j = 0; j < 8; ++j) { const int a = (int)s[(4 * j) * 33], b = (int)s[(4 * j + 1) * 33], c = (int)s[(4 * j + 2) * 33], d = (int)s[(4 * j + 3) * 33];
        pk[j] = (unsigned)(a & 255) | ((unsigned)(b & 255) << 8) | ((unsigned)(c & 255) << 16) | ((unsigned)(d & 255) << 24); }
    if (n0 + n < N) { GAS v4u* dst = (GAS v4u*)(W8 + (size_t)rm(n0 + n) * K + k0 + 32 * hf); dst[0] = (v4u){pk[0], pk[1], pk[2], pk[3]}; dst[1] = (v4u){pk[4], pk[5], pk[6], pk[7]}; }
    LDS_WAIT(); asm volatile("" ::: "memory");
}
__device__ __forceinline__ void xquant_phase(Frame& F, int ver) {
    int tid_ = F.wave * 64 + lane_id_now(); unsigned char* ws_ = F.ws; asm volatile("" : "+s"(ws_));
    const int lane = tid_ & 63, gw = blockIdx.x * NWAVES + (tid_ >> 6), NGW = F.G * NWAVES;
    const GAS bf16* XB = (const GAS bf16*)(ws_ + WS_XB); GAS signed char* XQ = (GAS signed char*)(ws_ + WS_XQ); GAS float* SX = (GAS float*)(ws_ + WS_SX); const GAS pg8::u64_t* SS = (const GAS pg8::u64_t*)(ws_ + WS_SSP) + (size_t)ver * T;
    for (int row = gw; row < T; row += NGW) {
        const GAS v4u* src = (const GAS v4u*)(XB + (size_t)row * DM + 16 * lane); const v4u a = src[0], b = src[1];
        const unsigned wd[8] = {a.x, a.y, a.z, a.w, b.x, b.y, b.z, b.w};
        float f[16]; float mx = 0.f;
#pragma unroll
        for (int j = 0; j < 8; ++j) { f[2 * j] = bflo(wd[j]); f[2 * j + 1] = bfhi(wd[j]); mx = fmaxf(mx, fmaxf(fabsf(f[2 * j]), fabsf(f[2 * j + 1]))); }
#pragma unroll
        for (int o = 1; o < 64; o <<= 1) mx = fmaxf(mx, __shfl_xor(mx, o));
        const float inv = mx > 0.f ? 127.0f / mx : 0.f;
        unsigned pk[4];
#pragma unroll
        for (int j = 0; j < 4; ++j) { const int q0 = (int)__builtin_rintf(f[4 * j] * inv), q1 = (int)__builtin_rintf(f[4 * j + 1] * inv), q2 = (int)__builtin_rintf(f[4 * j + 2] * inv), q3 = (int)__builtin_rintf(f[4 * j + 3] * inv);
            pk[j] = (unsigned)(q0 & 255) | ((unsigned)(q1 & 255) << 8) | ((unsigned)(q2 & 255) << 16) | ((unsigned)(q3 & 255) << 24); }
        *(GAS v4u*)(XQ + (size_t)row * DM + 16 * lane) = (v4u){pk[0], pk[1], pk[2], pk[3]};
        if (lane == 0) SX[row] = mx * (1.0f / 127.0f) * __builtin_amdgcn_rsqf(pg8::ss_val(SS[row]) * (1.0f / 1024.0f) + 1e-6f);
    }
}
struct RmNat { int off; __device__ __forceinline__ int operator()(int n) const { return n + off; } };
struct RmGate { int off; __device__ __forceinline__ int operator()(int n) const { return (n >> 7) * 256 + off + (n & 127); } };
__device__ __forceinline__ int headperm(int c) { const int h = c >> 6, d = c & 63; return 256 * (h >> 2) + 128 * (d >> 5) + 32 * (h & 3) + (d & 31); }
struct RmIn { __device__ __forceinline__ int operator()(int n) const {
    if (n < 1536) return (n / 512) * 512 + headperm(n % 512);
    if (n < 1792) return n;
    if (n < 1856) return 2304 + (n - 1792);
    if (n < 1860) return 2304 + 64 + (n - 1856);
    if (n < 2116) return 1792 + (n - 1860);
    return 2048 + headperm(n - 2116); } };
struct RmKV { int layer; __device__ __forceinline__ int operator()(int n) const { return layer * 512 + (n >> 8) * 256 + headperm(n & 255); } };
__device__ __forceinline__ void p0_prologue(Frame& F, const Args& args) {
    LAS float* scr = (LAS float*)(F.lds + RING_OFF + F.wave * 16384);
    const int gw = blockIdx.x * NWAVES + F.wave, NGW = F.G * NWAVES, lane = F.lane;
    constexpr int I_GU = (DM / 64) * (DFF / 32), I_D = (DFF / 64) * (DM / 32), I_IN = (DM / 64) * ((DIN + 31) / 32), I_OUT = (DM / 64) * (DM / 32), I_KV = (DM / 64) * (512 / 32);
    constexpr int PER_LAYER = 4 * I_GU + 2 * I_D + I_IN + I_OUT + I_KV;
    for (int it = gw; it < DEPTH * PER_LAYER; it += NGW) {
        const int l = it / PER_LAYER; int r = it % PER_LAYER;
        unsigned char* wl = F.ws + WS_W + (size_t)l * WL_STRIDE;
        unsigned* cmx = (unsigned*)(F.ws + WS_CMX) + (size_t)l * 2 * NGU;
        if (r < I_GU) { cmax_item(args.in[3] + (size_t)l * DM * DFF, DM, DFF, args.in[2] + l * DM, cmx, RmGate{0}, r, lane); continue; } r -= I_GU;
        if (r < I_GU) { cmax_item(args.in[4] + (size_t)l * DM * DFF, DM, DFF, args.in[2] + l * DM, cmx, RmGate{128}, r, lane); continue; } r -= I_GU;
        if (r < I_D)  { tr_item(args.in[5] + (size_t)l * DFF * DM, DFF, DM, nullptr, (bf16*)(wl + WL_1D), RmNat{0}, scr, r, lane); continue; } r -= I_D;
        if (r < I_GU) { cmax_item(args.in[18] + (size_t)l * DM * DFF, DM, DFF, args.in[17] + l * DM, cmx + NGU, RmGate{0}, r, lane); continue; } r -= I_GU;
        if (r < I_GU) { cmax_item(args.in[19] + (size_t)l * DM * DFF, DM, DFF, args.in[17] + l * DM, cmx + NGU, RmGate{128}, r, lane); continue; } r -= I_GU;
        if (r < I_D)  { tr_item(args.in[20] + (size_t)l * DFF * DM, DFF, DM, nullptr, (bf16*)(wl + WL_2D), RmNat{0}, scr, r, lane); continue; } r -= I_D;
        if (r < I_IN) { tr_item(args.in[8] + (size_t)l * DM * DIN, DM, DIN, args.in[6] + l * DM, (bf16*)(wl + WL_IN), RmIn{}, scr, r, lane); continue; } r -= I_IN;
        if (r < I_OUT) { const int kb = r / 32, nb = r % 32;
            if (kb >= 8 && kb < 12) tr_item_pool(args.in[16] + (size_t)l * DM * DM, args.in[11] + (size_t)l * 4 * 64 * 64, args.in[12] + l * 256, (bf16*)(wl + WL_OUT), scr, kb - 8, nb, lane);
            else tr_item(args.in[16] + (size_t)l * DM * DM, DM, DM, nullptr, (bf16*)(wl + WL_OUT), RmNat{0}, scr, r, lane);
            continue; } r -= I_OUT;
        tr_item(args.in[13] + (size_t)l * DM * 512, DM, 512, args.in[7] + l * DM, (bf16*)(F.ws + WS_WKV), RmKV{l}, scr, r, lane);
    }
    if (blockIdx.x == 0) { float* gn = (float*)(F.ws + WS_GN); for (int i = F.tid; i < 4 * DEPTH * 64; i += NWAVES * 64) { const int ty = i / (DEPTH * 64), r = i % (DEPTH * 64); gn[i] = (ty == 0 ? args.in[9] : ty == 1 ? args.in[10] : ty == 2 ? args.in[14] : args.in[15])[r]; } }
    for (int it = gw; it < DEPTH * 188; it += NGW) { const int l = it / 188, rr = 2304 + 68 + it % 188;
        GAS v4u* p = (GAS v4u*)((bf16*)(F.ws + WS_W + (size_t)l * WL_STRIDE + WL_IN) + (size_t)rr * DM); p[lane] = (v4u){0u, 0u, 0u, 0u}; p[lane + 64] = (v4u){0u, 0u, 0u, 0u}; }
    for (int m = gw; m < T + 512; m += NGW) {
        const bool ismem = m >= T; const int row = ismem ? m - T : m;
        const GAS f32x4* xr = (const GAS f32x4*)((ismem ? args.in[1] : args.in[0]) + (size_t)row * DM) + lane;
        f32x4 v[4]; float s = 0.f;
#pragma unroll
        for (int j = 0; j < 4; ++j) { v[j] = xr[64 * j]; s += (v[j][0] * v[j][0] + v[j][1] * v[j][1]) + (v[j][2] * v[j][2] + v[j][3] * v[j][3]); }
        s = wave_sum(s);
        if (lane == 0) { if (ismem) ((float*)(F.ws + WS_SSM))[row] = s; else ((pg8::u64_t*)(F.ws + WS_SSP))[row] = (pg8::u64_t)(s * pg8::SS_FIX); }
        GAS unsigned long long* o8 = (GAS unsigned long long*)((bf16*)(F.ws + (ismem ? WS_MEMB : WS_XB)) + (size_t)row * DM) + lane;
#pragma unroll
        for (int j = 0; j < 4; ++j) o8[64 * j] = (unsigned long long)pk2(v[j][0], v[j][1]) | ((unsigned long long)pk2(v[j][2], v[j][3]) << 32);
    }
}

__device__ __forceinline__ void p0b_quant(Frame& F, const Args& args) {
    LAS float* scr = (LAS float*)(F.lds + RING_OFF + F.wave * 16384);
    const int lane = lane_id_now(), gw = blockIdx.x * NWAVES + F.wave, NGW = F.G * NWAVES;
    constexpr int I_GU = (DM / 64) * (DFF / 32);
    for (int it = gw; it < DEPTH * 4 * I_GU; it += NGW) {
        const int l = it / (4 * I_GU); int r = it % (4 * I_GU); const int f = r / (2 * I_GU); r %= 2 * I_GU; const int up = r / I_GU; r %= I_GU;
        const float* W = (f == 0 ? (up ? args.in[4] : args.in[3]) : (up ? args.in[19] : args.in[18])) + (size_t)l * DM * DFF; const float* gn = (f == 0 ? args.in[2] : args.in[17]) + l * DM;
        signed char* W8 = (signed char*)(F.ws + WS_W + (size_t)l * WL_STRIDE + (f == 0 ? WL_1GU : WL_2GU));
        const unsigned* cmx = (const unsigned*)(F.ws + WS_CMX) + ((size_t)l * 2 + f) * NGU; float* sw = (float*)(F.ws + WS_SW) + ((size_t)l * 2 + f) * NGU;
        q8_item(W, DM, DFF, gn, W8, cmx, sw, RmGate{up ? 128 : 0}, scr, r, lane);
    }
}
__device__ __forceinline__ void pool_phase(Frame& F) {
    int tid_ = F.wave * 64 + lane_id_now(); unsigned char* ws_ = F.ws; asm volatile("" : "+s"(ws_));
    const bf16* PU = (const bf16*)(ws_ + WS_PU); bf16* CAT = (bf16*)(ws_ + WS_CAT);
    for (int it = blockIdx.x * 512 + tid_; it < T * 32; it += F.G * 512) {
        const int q = it >> 5, ch = it & 31, t = q & (SEQ - 1), g = ch >> 3, win = 2 << g, n = (t + 1 < win) ? t + 1 : win;
        float a[8] = {0.f, 0.f, 0.f, 0.f, 0.f, 0.f, 0.f, 0.f}, u0[8];
        for (int j = 0; j < n; ++j) { const v4u v = *(const v4u*)(PU + (size_t)(q - j) * 256 + 8 * ch);
            const float f[8] = {bflo(v.x), bfhi(v.x), bflo(v.y), bfhi(v.y), bflo(v.z), bfhi(v.z), bflo(v.w), bfhi(v.w)};
#pragma unroll
            for (int e = 0; e < 8; ++e) { a[e] += f[e]; if (j == 0) u0[e] = f[e]; } }
        const float inv = 1.0f / (float)n;
        v4u o; o.x = pk2(a[0] * inv - u0[0], a[1] * inv - u0[1]); o.y = pk2(a[2] * inv - u0[2], a[3] * inv - u0[3]); o.z = pk2(a[4] * inv - u0[4], a[5] * inv - u0[5]); o.w = pk2(a[6] * inv - u0[6], a[7] * inv - u0[7]);
        *(v4u*)(CAT + (size_t)q * 1024 + 512 + 8 * ch) = o;
    }
}
namespace att {
typedef float f32x16 __attribute__((ext_vector_type(16)));
typedef short s16x4 __attribute__((ext_vector_type(4)));
typedef short v4i16_t __attribute__((ext_vector_type(4)));
constexpr int SLOTB = 8192;
constexpr int L_K = 0, L_V = 4 * SLOTB, L_M = 8 * SLOTB, L_SC = L_M + 8 * 2048, L_OST = L_SC + 1024, L_END = L_OST + 8 * 4096;
static_assert(L_END <= 131072, "attention LDS");
__device__ __forceinline__ void glds16(const void* gsrc, unsigned lds_dst) { unsigned keep;
    asm volatile("s_mov_b32 %0, m0\n\ts_mov_b32 m0, %2\n\ts_nop 0\n\tglobal_load_lds_dwordx4 %1, off\n\ts_mov_b32 m0, %0" : "=&s"(keep) : "v"(gsrc), "s"(lds_dst) : "memory"); }
__device__ __forceinline__ void glds16s(const void* sbase, unsigned voff, unsigned lds_dst) { unsigned keep;
    asm volatile("s_mov_b32 %0, m0\n\ts_mov_b32 m0, %3\n\ts_nop 0\n\tglobal_load_lds_dwordx4 %1, %2\n\ts_mov_b32 m0, %0" : "=&s"(keep) : "v"(voff), "s"(sbase), "s"(lds_dst) : "memory"); }
__device__ __forceinline__ s16x4 vtr(LAS const unsigned char* p) { return __builtin_bit_cast(s16x4, __builtin_amdgcn_ds_read_tr16_b64_v4i16((LAS v4i16_t*)p)); }
__device__ __forceinline__ unsigned cvtpk(float lo, float hi) { typedef float f2 __attribute__((ext_vector_type(2))); typedef __bf16 b2 __attribute__((ext_vector_type(2))); f2 v = {lo, hi}; b2 b = __builtin_convertvector(v, b2); return __builtin_bit_cast(unsigned, b); }
__device__ __forceinline__ int crow(int r, int hi) { return (r & 3) + 8 * (r >> 2) + 4 * hi; }
__device__ __forceinline__ float maskexp(float x, unsigned w, int pos) {
    const unsigned m = (unsigned)__builtin_amdgcn_sbfe((int)w, pos, 1);
    const unsigned xb = (__builtin_bit_cast(unsigned, x) & m) | (0xff800000u & ~m);
    return __builtin_amdgcn_exp2f(__builtin_bit_cast(float, xb));
}

template <bool MEM>
__device__ __forceinline__ void unit(int h, int qb, const bf16* Qg, const bf16* Kg, const bf16* Vg, const unsigned* BMb, bf16* CATb, LAS unsigned char* lds, int tid, float moff) {
    constexpr int PQ = MEM ? 256 : 512;
    const int lane = tid & 63, r32 = lane & 31, hi = lane >> 5; const int wid = __builtin_amdgcn_readfirstlane(tid >> 6);
    const int q0 = qb * 256, qrow = q0 + wid * 32 + r32;
    const bf16* Qw = Qg + (size_t)qrow * PQ + h * 64;
    const unsigned lds0 = (unsigned)(uintptr_t)lds;
    const int krow = MEM ? lane : ((((lane >> 2) & 1) << 5) | ((lane >> 5) << 4) | (((lane >> 3) & 3) << 2) | (lane & 3));
    const unsigned ksrc = MEM ? (unsigned)(h * 64 + krow * PQ + wid * 8) * 2u : (unsigned)(h * 64 + krow * 512 + (wid & 3) * 16);
    const bool kq = MEM || wid < 4;
    const unsigned vsrc = MEM ? (unsigned)(h * 64 + (16 * (wid & 3) + (lane >> 2)) * PQ + (wid >> 2) * 32 + (lane & 3) * 8) * 2u
                              : (unsigned)((h * 64 + lane) * SEQ + (wid & 3) * 16);
    const bool vq = MEM || wid >= 4;
    const unsigned kdst = lds0 + L_K + wid * 1024, vdst8 = lds0 + L_V + (MEM ? wid : (wid & 3)) * 1024, mdst = lds0 + L_M + wid * 2048;
    const unsigned msrc = (unsigned)((q0 + wid * 32 + (lane >> 1)) * 512 + (lane & 1) * 4) * 4u;
    const int NT = MEM ? 4 : (q0 + 256) / 64;
#define ATT_DMA_K(t) if (kq) glds16s(Kg, ksrc + (unsigned)(t) * (MEM ? 64 * PQ * 2 : 64 * 512), (unsigned)__builtin_amdgcn_readfirstlane(kdst + (unsigned)((t) & 3) * SLOTB))
#define ATT_DMA_V(t) if (vq) glds16s(Vg, vsrc + (unsigned)(t) * (MEM ? 64 * PQ * 2 : 64), (unsigned)__builtin_amdgcn_readfirstlane(vdst8 + (unsigned)((t) & 3) * SLOTB))
#define ATT_DMA_KS(t, slot) if (kq) glds16s(Kg, ksrc + (unsigned)(t) * (MEM ? 64 * PQ * 2 : 64 * 512), (unsigned)__builtin_amdgcn_readfirstlane(kdst + (unsigned)(slot) * SLOTB))
#define ATT_DMA_VS(t, slot) if (vq) glds16s(Vg, vsrc + (unsigned)(t) * (MEM ? 64 * PQ * 2 : 64), (unsigned)__builtin_amdgcn_readfirstlane(vdst8 + (unsigned)(slot) * SLOTB))
#define ATT_DMA_M(g) glds16s(BMb, msrc + (unsigned)(g) * 32, (unsigned)__builtin_amdgcn_readfirstlane(mdst + (unsigned)((g) & 1) * 1024))
#define ATT_QK(P0, P1, t) do { LAS const unsigned char* Ks_ = (LAS const unsigned char*)(uintptr_t)(((unsigned)(uintptr_t)(lds + L_K + ((t) & 3) * SLOTB + hi * 1024 + r32 * 16)) & 0x3ffffu); P0 = cinit; P1 = cinit; \
        _Pragma("unroll") for (int d0 = 0; d0 < 4; ++d0) { const bf16x8 b0 = *(LAS const bf16x8*)(Ks_ + d0 * 2048), b1 = *(LAS const bf16x8*)(Ks_ + d0 * 2048 + 512); \
            P0 = __builtin_amdgcn_mfma_f32_32x32x16_bf16(b0, qr[d0], P0, 0, 0, 0); P1 = __builtin_amdgcn_mfma_f32_32x32x16_bf16(b1, qr[d0], P1, 0, 0, 0); } } while (0)
    bf16x8 qr[4];
    typedef int v4i_ __attribute__((ext_vector_type(4))); typedef int v8i_ __attribute__((ext_vector_type(8)));
    v8i_ q8 = {0, 0, 0, 0, 0, 0, 0, 0};
    if (MEM) {
#pragma unroll
        for (int d0 = 0; d0 < 4; ++d0) qr[d0] = *(const bf16x8*)(Qw + d0 * 16 + hi * 8); }
    else { const unsigned char* Q8 = (const unsigned char*)Qg + (size_t)qrow * 512 + h * 64 + 32 * hi;
        const v4i_ lo = *(const v4i_*)Q8, hi4 = *(const v4i_*)(Q8 + 16); q8 = __builtin_shufflevector(lo, hi4, 0, 1, 2, 3, 4, 5, 6, 7); }
    v8i_ ones8 = {0x38383838, 0x38383838, 0x38383838, 0x38383838, 0x38383838, 0x38383838, 0x38383838, 0x38383838};
    v8i_ pw8 = {0, 0, 0, 0, 0, 0, 0, 0}, pwb = {0, 0, 0, 0, 0, 0, 0, 0};
#define ATT_PV8P(P_, O, lo_, hi_) O = __builtin_amdgcn_mfma_scale_f32_32x32x64_f8f6f4(P_, __builtin_shufflevector(__builtin_bit_cast(v4i_, lo_), __builtin_bit_cast(v4i_, hi_), 0, 1, 2, 3, 4, 5, 6, 7), O, 0, 0, 0, 0, 0, 0)
#define ATT_PV8(O, lo_, hi_) O = __builtin_amdgcn_mfma_scale_f32_32x32x64_f8f6f4(pw8, __builtin_shufflevector(__builtin_bit_cast(v4i_, lo_), __builtin_bit_cast(v4i_, hi_), 0, 1, 2, 3, 4, 5, 6, 7), O, 0, 0, 0, 0, 0, 0)
#define ATT_QK8(P, lo_, hi_) P = __builtin_amdgcn_mfma_scale_f32_32x32x64_f8f6f4(__builtin_shufflevector(__builtin_bit_cast(v4i_, lo_), __builtin_bit_cast(v4i_, hi_), 0, 1, 2, 3, 4, 5, 6, 7), q8, cinit, 0, 0, 0, 0, 0, 0)
    f32x16 o0, o1, o2; const f32x16 cinit = {0.f, 0.f, 0.f, 0.f, 0.f, 0.f, 0.f, 0.f, 0.f, 0.f, 0.f, 0.f, 0.f, 0.f, 0.f, 0.f};
#pragma unroll
    for (int r = 0; r < 16; ++r) { o0[r] = 0.f; o1[r] = 0.f; o2[r] = 0.f; }
    (void)moff;
    asm volatile("" ::: "memory");
    if (!MEM) { ATT_DMA_M(0); *(LAS v4u*)(lds + L_V + 3 * SLOTB + wid * 1024 + lane * 16) = (v4u){0u, 0u, 0u, 0u};
        { const unsigned nb = (unsigned)(tid >> 1) >> ((tid & 1) * 4);
          ((LAS unsigned*)(lds + L_K + 4096))[tid] = ((nb & 1) ? 0xffu : 0u) | ((nb & 2) ? 0xff00u : 0u) | ((nb & 4) ? 0xff0000u : 0u) | ((nb & 8) ? 0xff000000u : 0u); } }
    ATT_DMA_K(0); ATT_DMA_V(0); ATT_DMA_K(1);
    asm volatile("s_waitcnt vmcnt(0) lgkmcnt(0)\n\ts_barrier" ::: "memory");
    ATT_DMA_K(2); ATT_DMA_V(1);
    ATT_DMA_K(3); ATT_DMA_V(2);
    f32x16 s0, s1;
    if (MEM) ATT_QK(s0, s1, 0);
    else { LAS const unsigned char* K0 = (LAS const unsigned char*)(uintptr_t)(((unsigned)(uintptr_t)(lds + L_K + hi * 2048 + r32 * 16)) & 0x3ffffu);
        const bf16x8 a0 = *(LAS const bf16x8*)(K0 + 0), a1 = *(LAS const bf16x8*)(K0 + 1024), b0 = *(LAS const bf16x8*)(K0 + 512), b1 = *(LAS const bf16x8*)(K0 + 1536);
        ATT_QK8(s0, a0, a1); ATT_QK8(s1, b0, b1); }
    typedef float f32x2 __attribute__((ext_vector_type(2)));
    f32x2 la0 = {0.f, 0.f}, la1 = {0.f, 0.f};
    bf16x8 fp[4]; unsigned long long mwp = 0ull; unsigned mkp[8] = {0u, 0u, 0u, 0u, 0u, 0u, 0u, 0u};
    if (!MEM) { __builtin_amdgcn_s_setreg(1 | (23 << 6), 1);
        LAS const unsigned char* V0 = (LAS const unsigned char*)(uintptr_t)(((unsigned)(uintptr_t)(lds + L_V + hi * 2048 + r32 * 16)) & 0x3ffffu);
        fp[0] = *(LAS const bf16x8*)(V0 + 0); fp[1] = *(LAS const bf16x8*)(V0 + 1024); fp[2] = *(LAS const bf16x8*)(V0 + 512); fp[3] = *(LAS const bf16x8*)(V0 + 1536);
        mwp = *(LAS const unsigned long long*)(lds + L_M + wid * 2048 + r32 * 32);
        { const unsigned cw = hi ? (unsigned)(mwp >> 32) : (unsigned)mwp;
#pragma unroll
          for (int j = 0; j < 4; ++j) { typedef unsigned u2_ __attribute__((ext_vector_type(2))); const u2_ m2 = *(LAS const u2_*)(lds + L_K + 4096 + ((j == 0 ? (cw << 3) : (cw >> (8 * j - 3))) & 0x7f8u)); mkp[2 * j] = m2[0]; mkp[2 * j + 1] = m2[1]; } } }
    const bool late = wid >= 4;
    v4u pw[4];
#pragma unroll
    for (int i = 0; i < 4; ++i) pw[i] = (v4u){0u, 0u, 0u, 0u};
    auto pv = [&](const int tv) __attribute__((always_inline)) {
        if (MEM) {
        LAS const unsigned char* Vs = (LAS const unsigned char*)(uintptr_t)(((unsigned)(uintptr_t)(lds + L_V + (tv & 3) * SLOTB + ((lane >> 4) & 1) * 32 + (lane & 3) * 8 + (4 * hi + ((lane & 15) >> 2)) * 64)) & 0x3ffffu);
#pragma unroll
        for (int ks = 0; ks < 4; ++ks) {
            const s16x4 l0 = vtr(Vs + ks * 1024), h0 = vtr(Vs + ks * 1024 + 512), l1 = vtr(Vs + 4096 + ks * 1024), h1 = vtr(Vs + 4096 + ks * 1024 + 512);
            const bf16x8 v0 = (bf16x8){l0[0], l0[1], l0[2], l0[3], h0[0], h0[1], h0[2], h0[3]}, v1 = (bf16x8){l1[0], l1[1], l1[2], l1[3], h1[0], h1[1], h1[2], h1[3]};
            const bf16x8 pa = __builtin_bit_cast(bf16x8, pw[ks]);
            o0 = __builtin_amdgcn_mfma_f32_32x32x16_bf16(pa, v0, o0, 0, 0, 0);
            o1 = __builtin_amdgcn_mfma_f32_32x32x16_bf16(pa, v1, o1, 0, 0, 0);
        }
        } else {
            LAS const unsigned char* Vt = (LAS const unsigned char*)(uintptr_t)(((unsigned)(uintptr_t)(lds + L_V + (tv & 3) * SLOTB + hi * 1024 + r32 * 16)) & 0x3ffffu);
#pragma unroll
            for (int ks = 0; ks < 4; ++ks) {
                const bf16x8 v0 = *(LAS const bf16x8*)(Vt + ks * 2048), v1 = *(LAS const bf16x8*)(Vt + ks * 2048 + 512);
                const bf16x8 pa = __builtin_bit_cast(bf16x8, pw[ks]);
                o0 = __builtin_amdgcn_mfma_f32_32x32x16_bf16(pa, v0, o0, 0, 0, 0);
                o1 = __builtin_amdgcn_mfma_f32_32x32x16_bf16(pa, v1, o1, 0, 0, 0);
            }
        }
    };
    auto step = [&](f32x16& S0, f32x16& S1, f32x16& N0, f32x16& N1, const int t) __attribute__((always_inline)) {
        ATT_QK(N0, N1, t + 1);
        unsigned cw0 = 0xffffffffu, cw1 = 0xffffffffu;
        if (!MEM) { const unsigned long long mw = *(LAS const unsigned long long*)(lds + L_M + wid * 2048 + ((t >> 2) & 1) * 1024 + r32 * 32 + (t & 3) * 8);
            cw0 = (unsigned)mw >> (8 * hi); cw1 = (unsigned)(mw >> 32) >> (8 * hi); }
#pragma unroll
        for (int r = 0; r < 16; ++r) { const int pos = 16 * (r >> 3) + (r & 7);
            if (MEM) { S0[r] = __builtin_amdgcn_exp2f(S0[r]); S1[r] = __builtin_amdgcn_exp2f(S1[r]); }
            else { S0[r] = maskexp(S0[r], cw0, pos); S1[r] = maskexp(S1[r], cw1, pos); } }
#pragma unroll
        for (int r = 0; r < 16; r += 2) { la0 += (f32x2){S0[r], S0[r + 1]}; la1 += (f32x2){S1[r], S1[r + 1]}; }
#pragma unroll
        for (int kk = 0; kk < 2; ++kk) {
            pw[kk][0] = cvtpk(S0[8 * kk + 0], S0[8 * kk + 1]); pw[kk][1] = cvtpk(S0[8 * kk + 2], S0[8 * kk + 3]); pw[kk][2] = cvtpk(S0[8 * kk + 4], S0[8 * kk + 5]); pw[kk][3] = cvtpk(S0[8 * kk + 6], S0[8 * kk + 7]);
            pw[2 + kk][0] = cvtpk(S1[8 * kk + 0], S1[8 * kk + 1]); pw[2 + kk][1] = cvtpk(S1[8 * kk + 2], S1[8 * kk + 3]); pw[2 + kk][2] = cvtpk(S1[8 * kk + 4], S1[8 * kk + 5]); pw[2 + kk][3] = cvtpk(S1[8 * kk + 6], S1[8 * kk + 7]); }
        pv(t);
        const int c = ((t + 3 < NT) ? 1 : 0) + ((t + 2 < NT) ? 1 : 0);
        if (c == 2) asm volatile("s_waitcnt vmcnt(2) lgkmcnt(0)\n\ts_barrier" ::: "memory");
        else if (c == 1) asm volatile("s_waitcnt vmcnt(1) lgkmcnt(0)\n\ts_barrier" ::: "memory");
        else asm volatile("s_waitcnt vmcnt(0) lgkmcnt(0)\n\ts_barrier" ::: "memory");
        if (!MEM && (t & 3) == 0 && 4 * ((t >> 2) + 1) < NT) ATT_DMA_M((t >> 2) + 1);
        if (t + 4 < NT) ATT_DMA_K(t + 4);
        if (t + 3 < NT) ATT_DMA_V(t + 3);
    };
    auto step_late = [&](f32x16& S0, f32x16& S1, f32x16& N0, f32x16& N1, v8i_& PO, v8i_& PN, const int t, const int tm) __attribute__((always_inline)) {
        LAS const unsigned char* Vn = (LAS const unsigned char*)(uintptr_t)(((unsigned)(uintptr_t)(lds + L_V + tm * SLOTB + hi * 2048 + r32 * 16)) & 0x3ffffu);
        LAS const unsigned char* Kt = (LAS const unsigned char*)(uintptr_t)(((unsigned)(uintptr_t)(lds + L_K + ((tm + 1) & 3) * SLOTB + hi * 2048 + r32 * 16)) & 0x3ffffu);
        unsigned mk[8];
#pragma unroll
        for (int j = 0; j < 8; ++j) mk[j] = mkp[j];
        const unsigned long long mwn = *(LAS const unsigned long long*)(lds + L_M + wid * 2048 + (((t + 1) >> 2) & 1) * 1024 + r32 * 32 + ((tm + 1) & 3) * 8);
        bf16x8 f[8];
        f[0] = fp[0]; f[1] = fp[1]; f[2] = fp[2]; f[3] = fp[3];
        f[4] = *(LAS const bf16x8*)(Kt + 0); f[5] = *(LAS const bf16x8*)(Kt + 1024); ATT_PV8P(PO, o0, f[0], f[1]); asm volatile("" : "+v"(o0)); S0[0] = __builtin_amdgcn_exp2f(S0[0]); S0[1] = __builtin_amdgcn_exp2f(S0[1]); S0[2] = __builtin_amdgcn_exp2f(S0[2]); S0[3] = __builtin_amdgcn_exp2f(S0[3]); S0[4] = __builtin_amdgcn_exp2f(S0[4]); S0[5] = __builtin_amdgcn_exp2f(S0[5]); S0[6] = __builtin_amdgcn_exp2f(S0[6]); S0[7] = __builtin_amdgcn_exp2f(S0[7]); __builtin_amdgcn_sched_barrier(0);
        f[6] = *(LAS const bf16x8*)(Kt + 512); f[7] = *(LAS const bf16x8*)(Kt + 1536); ATT_PV8P(PO, o1, f[2], f[3]); asm volatile("" : "+v"(o1)); S0[8] = __builtin_amdgcn_exp2f(S0[8]); S0[9] = __builtin_amdgcn_exp2f(S0[9]); S0[10] = __builtin_amdgcn_exp2f(S0[10]); S0[11] = __builtin_amdgcn_exp2f(S0[11]); S0[12] = __builtin_amdgcn_exp2f(S0[12]); S0[13] = __builtin_amdgcn_exp2f(S0[13]); S0[14] = __builtin_amdgcn_exp2f(S0[14]); S0[15] = __builtin_amdgcn_exp2f(S0[15]); __builtin_amdgcn_sched_barrier(0);
        o2 = __builtin_amdgcn_mfma_scale_f32_32x32x64_f8f6f4(PO, ones8, o2, 0, 0, 0, 0, 0, 0); asm volatile("" : "+v"(o2)); S1[0] = __builtin_amdgcn_exp2f(S1[0]); S1[1] = __builtin_amdgcn_exp2f(S1[1]); S1[2] = __builtin_amdgcn_exp2f(S1[2]); S1[3] = __builtin_amdgcn_exp2f(S1[3]); S1[4] = __builtin_amdgcn_exp2f(S1[4]); S1[5] = __builtin_amdgcn_exp2f(S1[5]); S1[6] = __builtin_amdgcn_exp2f(S1[6]); S1[7] = __builtin_amdgcn_exp2f(S1[7]); __builtin_amdgcn_sched_barrier(0);
        ATT_QK8(N0, f[4], f[5]); asm volatile("" : "+v"(N0)); S1[8] = __builtin_amdgcn_exp2f(S1[8]); S1[9] = __builtin_amdgcn_exp2f(S1[9]); S1[10] = __builtin_amdgcn_exp2f(S1[10]); S1[11] = __builtin_amdgcn_exp2f(S1[11]); S1[12] = __builtin_amdgcn_exp2f(S1[12]); S1[13] = __builtin_amdgcn_exp2f(S1[13]); S1[14] = __builtin_amdgcn_exp2f(S1[14]); S1[15] = __builtin_amdgcn_exp2f(S1[15]); PN[0] = __builtin_amdgcn_cvt_pk_fp8_f32(S0[0], S0[1], PN[0], false); PN[0] = __builtin_amdgcn_cvt_pk_fp8_f32(S0[2], S0[3], PN[0], true); PN[0] &= mk[0]; PN[1] = __builtin_amdgcn_cvt_pk_fp8_f32(S0[4], S0[5], PN[1], false); PN[1] = __builtin_amdgcn_cvt_pk_fp8_f32(S0[6], S0[7], PN[1], true); PN[1] &= mk[1]; asm volatile("" : "+v"(PN)); __builtin_amdgcn_sched_barrier(0);
        ATT_QK8(N1, f[6], f[7]); asm volatile("" : "+v"(N1)); PN[2] = __builtin_amdgcn_cvt_pk_fp8_f32(S0[8], S0[9], PN[2], false); PN[2] = __builtin_amdgcn_cvt_pk_fp8_f32(S0[10], S0[11], PN[2], true); PN[2] &= mk[2]; PN[3] = __builtin_amdgcn_cvt_pk_fp8_f32(S0[12], S0[13], PN[3], false); PN[3] = __builtin_amdgcn_cvt_pk_fp8_f32(S0[14], S0[15], PN[3], true); PN[3] &= mk[3]; PN[4] = __builtin_amdgcn_cvt_pk_fp8_f32(S1[0], S1[1], PN[4], false); PN[4] = __builtin_amdgcn_cvt_pk_fp8_f32(S1[2], S1[3], PN[4], true); PN[4] &= mk[4]; PN[5] = __builtin_amdgcn_cvt_pk_fp8_f32(S1[4], S1[5], PN[5], false); PN[5] = __builtin_amdgcn_cvt_pk_fp8_f32(S1[6], S1[7], PN[5], true); PN[5] &= mk[5]; PN[6] = __builtin_amdgcn_cvt_pk_fp8_f32(S1[8], S1[9], PN[6], false); PN[6] = __builtin_amdgcn_cvt_pk_fp8_f32(S1[10], S1[11], PN[6], true); PN[6] &= mk[6]; PN[7] = __builtin_amdgcn_cvt_pk_fp8_f32(S1[12], S1[13], PN[7], false); PN[7] = __builtin_amdgcn_cvt_pk_fp8_f32(S1[14], S1[15], PN[7], true); PN[7] &= mk[7]; asm volatile("" : "+v"(PN)); __builtin_amdgcn_sched_barrier(0);
        fp[0] = *(LAS const bf16x8*)(Vn + 0); fp[1] = *(LAS const bf16x8*)(Vn + 1024); fp[2] = *(LAS const bf16x8*)(Vn + 512); fp[3] = *(LAS const bf16x8*)(Vn + 1536);
        { const unsigned cw = hi ? (unsigned)(mwn >> 32) : (unsigned)mwn;
#pragma unroll
          for (int j = 0; j < 4; ++j) { typedef unsigned u2_ __attribute__((ext_vector_type(2))); const u2_ m2 = *(LAS const u2_*)(lds + L_K + 4096 + ((j == 0 ? (cw << 3) : (cw >> (8 * j - 3))) & 0x7f8u)); mkp[2 * j] = m2[0]; mkp[2 * j + 1] = m2[1]; } }
        const int c = ((kq && t + 3 < NT) ? 1 : 0) + ((vq && t + 2 < NT) ? 1 : 0);
        if (c == 2) asm volatile("s_waitcnt vmcnt(2) lgkmcnt(0)\n\ts_barrier" ::: "memory");
        else if (c == 1) asm volatile("s_waitcnt vmcnt(1) lgkmcnt(0)\n\ts_barrier" ::: "memory");
        else asm volatile("s_waitcnt vmcnt(0) lgkmcnt(0)\n\ts_barrier" ::: "memory");
        if (tm == 0 && 4 * ((t >> 2) + 1) < NT) ATT_DMA_M((t >> 2) + 1);
        if (t + 4 < NT) ATT_DMA_KS(t + 4, tm);
        if (t + 3 < NT) ATT_DMA_VS(t + 3, (tm + 3) & 3);
    };
    f32x16 n0, n1;
#pragma unroll 1
    for (int t = 0; t < NT; t += 2) {
        if (!MEM) { step_late(s0, s1, n0, n1, pw8, pwb, t, 0); step_late(n0, n1, s0, s1, pwb, pw8, t + 1, 1); step_late(s0, s1, n0, n1, pw8, pwb, t + 2, 2); step_late(n0, n1, s0, s1, pwb, pw8, t + 3, 3); t += 2; }
        else { step(s0, s1, n0, n1, t); step(n0, n1, s0, s1, t + 1); }
    }
    if (!MEM) { LAS const unsigned char* Vl = (LAS const unsigned char*)(uintptr_t)(((unsigned)(uintptr_t)(lds + L_V + ((NT - 1) & 3) * SLOTB + hi * 2048 + r32 * 16)) & 0x3ffffu);
        const bf16x8 v0 = *(LAS const bf16x8*)(Vl + 0), v1 = *(LAS const bf16x8*)(Vl + 1024), v2 = *(LAS const bf16x8*)(Vl + 512), v3 = *(LAS const bf16x8*)(Vl + 1536);
        ATT_PV8(o0, v0, v1); ATT_PV8(o1, v2, v3); o2 = __builtin_amdgcn_mfma_scale_f32_32x32x64_f8f6f4(pw8, ones8, o2, 0, 0, 0, 0, 0, 0); __builtin_amdgcn_s_setreg(1 | (23 << 6), 0); }
    float lsum = (la0[0] + la0[1]) + (la1[0] + la1[1]);
    lsum += __shfl_xor(lsum, 32);
    LAS float* sc = (LAS float*)(lds + L_SC) + wid * 32;
    LAS unsigned short* ost = (LAS unsigned short*)(lds + L_OST + wid * 4096);
    if (hi == 0) sc[r32] = lsum;
    asm volatile("s_waitcnt lgkmcnt(0)" ::: "memory");
#pragma unroll
    for (int r = 0; r < 16; ++r) { const int qq = crow(r, hi); const float inv = 1.0f / (MEM ? sc[qq] : fmaxf(o2[r], 1.0e-30f));
        ost[qq * 64 + r32] = (unsigned short)f2bf(o0[r] * inv); ost[qq * 64 + 32 + r32] = (unsigned short)f2bf(o1[r] * inv); }
    asm volatile("s_waitcnt lgkmcnt(0)" ::: "memory");
#pragma unroll
    for (int i = 0; i < 4; ++i) { const int row = (lane >> 3) + 8 * i, ch = lane & 7;
        const v4u v = *(LAS const v4u*)((LAS const unsigned char*)ost + row * 128 + ch * 16);
        *(v4u*)(CATb + (size_t)(q0 + wid * 32 + row) * 1024 + (MEM ? 768 : 0) + h * 64 + ch * 8) = v; }
    asm volatile("s_waitcnt vmcnt(0) lgkmcnt(0)\n\ts_barrier" ::: "memory");
#undef ATT_DMA_K
#undef ATT_DMA_V
#undef ATT_DMA_M
#undef ATT_QK
}
}
__device__ __forceinline__ void attn_dense_phase(Frame& F, int layer) {
    int tid_ = F.wave * 64 + lane_id_now(); unsigned char* ws_ = F.ws; asm volatile("" : "+s"(ws_));
    const int lane = tid_ & 63;
    const float* gn_ = (const float*)(ws_ + WS_GN) + layer * 64 + lane;
    float gq = fabsf(gn_[0]), gk = fabsf(gn_[DEPTH * 64]), gmq = fabsf(gn_[2 * DEPTH * 64]), gmk = fabsf(gn_[3 * DEPTH * 64]);
#pragma unroll
    for (int o = 1; o < 64; o <<= 1) { gq = fmaxf(gq, __shfl_xor(gq, o)); gk = fmaxf(gk, __shfl_xor(gk, o)); gmq = fmaxf(gmq, __shfl_xor(gmq, o)); gmk = fmaxf(gmk, __shfl_xor(gmk, o)); }
    const float moffA = 64.0f * C2 * gq * gk, moffM = 64.0f * C2 * gmq * gmk;
    const int G = F.G, v = (G % 8 == 0) ? ((int)blockIdx.x % 8) * (G / 8) + (int)blockIdx.x / 8 : (int)blockIdx.x;
    for (int i = 0;; ++i) {
        int bh, qb;
        if (G == 256) { if (i >= 4) break; const int c = v & 31; bh = (i >> 1) * 8 + (v >> 5); qb = (i & 1) ? 63 - c : c; }
        else { const int u = v + i * G; if (u >= 1024) break; bh = u & 15; qb = 63 - (u >> 4); }
        const int b = bh >> 3, h = bh & 7; const size_t rb = (size_t)b * SEQ;
        att::unit<false>(h, qb, (const bf16*)(ws_ + WS_AQ) + rb * 256, (const bf16*)(ws_ + WS_AK) + rb * 256, (const bf16*)(ws_ + WS_AV + (size_t)b * (8 * 64) * SEQ),
                         (const unsigned*)F.out + rb * 512, (bf16*)(ws_ + WS_CAT) + rb * 1024, F.lds, tid_, moffA);
    }
    for (int u = v; u < 512; u += G) { const int qb = u & 63, bh = u >> 6, b = bh >> 2, h = bh & 3; const size_t rb = (size_t)b * SEQ;
        att::unit<true>(h, qb, (const bf16*)(ws_ + WS_MQ) + rb * 256, (const bf16*)(ws_ + WS_MEMK) + (size_t)(layer * 2 + b) * 256 * 256, (const bf16*)(ws_ + WS_MEMV) + (size_t)(layer * 2 + b) * 256 * 256,
                        nullptr, (bf16*)(ws_ + WS_CAT) + rb * 1024, F.lds, tid_, moffM); }
}
namespace tk {
typedef float f32x16 __attribute__((ext_vector_type(16)));
constexpr int CAP = 1024;
constexpr int L_LIST = 0, L_CTL = 131072 + 1024, L_HIST = 131072 + 2048;
__device__ __forceinline__ unsigned sortable(float s) { unsigned u = __builtin_bit_cast(unsigned, s); if (u == 0x80000000u) u = 0u; return (u & 0x80000000u) ? ~u : (u | 0x80000000u); }
__device__ __forceinline__ float unsortable(unsigned u) { const unsigned b = (u & 0x80000000u) ? (u & 0x7fffffffu) : ~u; return __builtin_bit_cast(float, b); }
__device__ __forceinline__ int crow(int r, int hi) { return (r & 3) + 8 * (r >> 2) + 4 * hi; }
__device__ __forceinline__ int dpp_scan_add(int v) {
    v += __builtin_amdgcn_update_dpp(0, v, 0x111, 0xf, 0xf, true); v += __builtin_amdgcn_update_dpp(0, v, 0x112, 0xf, 0xf, true);
    v += __builtin_amdgcn_update_dpp(0, v, 0x114, 0xf, 0xf, true); v += __builtin_amdgcn_update_dpp(0, v, 0x118, 0xf, 0xf, true);
    v += __builtin_amdgcn_update_dpp(0, v, 0x142, 0xa, 0xf, false); v += __builtin_amdgcn_update_dpp(0, v, 0x143, 0xc, 0xf, false);
    return v;
}
__device__ __forceinline__ unsigned wave_or(unsigned v) {
    v |= (unsigned)__builtin_amdgcn_update_dpp(0, (int)v, 0x111, 0xf, 0xf, true); v |= (unsigned)__builtin_amdgcn_update_dpp(0, (int)v, 0x112, 0xf, 0xf, true);
    v |= (unsigned)__builtin_amdgcn_update_dpp(0, (int)v, 0x114, 0xf, 0xf, true); v |= (unsigned)__builtin_amdgcn_update_dpp(0, (int)v, 0x118, 0xf, 0xf, true);
    v |= (unsigned)__builtin_amdgcn_update_dpp(0, (int)v, 0x142, 0xa, 0xf, false); v |= (unsigned)__builtin_amdgcn_update_dpp(0, (int)v, 0x143, 0xc, 0xf, false);
    return (unsigned)__builtin_amdgcn_readlane((int)v, 63);
}
__device__ __forceinline__ unsigned select256(const unsigned (&e)[16], int n, int lane, LAS unsigned* hist, bool approx) {
    if (n <= NSEL) return 1u;
    unsigned xo = 0u, xn = 0u;
#pragma unroll
    for (int i = 0; i < 16; ++i) if (e[i] != 0u) { xo |= e[i]; xn |= ~e[i]; }
    xo = wave_or(xo); const unsigned xa = ~wave_or(xn);
    const unsigned diff = xo ^ xa;
    int pshift = 32 - __builtin_clz(diff | 1u);
    unsigned pval = (pshift >= 32) ? 0u : (xa >> pshift);
    int need = NSEL;
    while (pshift > 0) {
        const int shift = pshift > 8 ? pshift - 8 : 0, nbits = pshift - shift; const unsigned bmask = (1u << nbits) - 1u;
        *(LAS v4u*)(hist + 4 * lane) = (v4u){0u, 0u, 0u, 0u};
        asm volatile("s_waitcnt lgkmcnt(0)" ::: "memory");
#pragma unroll
        for (int i = 0; i < 16; ++i) { const bool in = (pshift >= 32) ? true : ((e[i] >> (pshift & 31)) == pval);
            const unsigned idx = in ? ((e[i] >> shift) & bmask) : (unsigned)(256 + lane);
            __hip_atomic_fetch_add(hist + idx, 1u, __ATOMIC_RELAXED, __HIP_MEMORY_SCOPE_WORKGROUP); }
        asm volatile("s_waitcnt lgkmcnt(0)" ::: "memory");
        const v4u c = *(LAS const v4u*)(hist + 4 * lane);
        const int ls = (int)(c[0] + c[1] + c[2] + c[3]);
        const int pre = dpp_scan_add(ls), tot = __builtin_amdgcn_readlane(pre, 63);
        const int incl = tot - pre + ls, above = incl - ls;
        const bool hit = (above < need) && (need <= incl);
        int bin = 0, nneed = 0, bcnt = 0;
        { int a = above;
            if (a + (int)c[3] >= need) { bin = 3; nneed = need - a; bcnt = (int)c[3]; } else { a += (int)c[3];
            if (a + (int)c[2] >= need) { bin = 2; nneed = need - a; bcnt = (int)c[2]; } else { a += (int)c[2];
            if (a + (int)c[1] >= need) { bin = 1; nneed = need - a; bcnt = (int)c[1]; } else { a += (int)c[1]; bin = 0; nneed = need - a; bcnt = (int)c[0]; } } }
            bin += 4 * lane; }
        const unsigned long long hm = __ballot(hit);
        const int src = __builtin_ctzll(hm | (1ull << 63));
        bin = __builtin_amdgcn_readlane(bin, src); nneed = __builtin_amdgcn_readlane(nneed, src); bcnt = __builtin_amdgcn_readlane(bcnt, src);
        pval = (pval << nbits) | (unsigned)bin; pshift = shift; need = nneed;
        if (bcnt == need || (approx && NSEL - need + bcnt <= 384)) break;
    }
    const unsigned tc_ = pshift >= 32 ? 0u : (pval << pshift);
    return tc_ == 0u ? 1u : tc_;
}
}
__device__ __forceinline__ void topk_fast_phase(Frame& F, int layer) {
    int tid_ = F.wave * 64 + lane_id_now(); unsigned char* ws_ = F.ws; asm volatile("" : "+s"(ws_));
    const int tid = tid_, lane = tid & 63, r32 = lane & 31, hi = lane >> 5, wid = __builtin_amdgcn_readfirstlane(tid >> 6);
    const GAS bf16* IQ = (const GAS bf16*)(ws_ + WS_IQ); const GAS bf16* IK = (const GAS bf16*)(ws_ + WS_IK); const GAS float* IW = (const GAS float*)(ws_ + WS_IW);
    GAS unsigned* BM = (GAS unsigned*)F.out;
    LAS unsigned* list = (LAS unsigned*)(F.lds + tk::L_LIST);
    LAS unsigned* cnt = (LAS unsigned*)(F.lds + tk::L_CTL); LAS float* tau = (LAS float*)(F.lds + tk::L_CTL + 128); LAS unsigned* flag = (LAS unsigned*)(F.lds + tk::L_CTL + 256);
    LAS unsigned* hist = (LAS unsigned*)(F.lds + tk::L_HIST) + wid * 320;
    const int G = F.G;
    (void)G;
    GAS unsigned* queue = (GAS unsigned*)(ws_ + WS_TKQ) + layer * 16;
    LAS unsigned* tick = flag + 8;
    if (tid == 0) tick[0] = __hip_atomic_fetch_add(queue, 1u, __ATOMIC_RELAXED, __HIP_MEMORY_SCOPE_AGENT);
    __syncthreads();
#pragma unroll 1
      for (;;) {
        const unsigned un = tick[0];
        if (un >= 1024u) break;
        unsigned nxt = 0u; if (tid == 0) nxt = __hip_atomic_fetch_add(queue, 1u, __ATOMIC_RELAXED, __HIP_MEMORY_SCOPE_AGENT);
        const int b = (int)(un & 1u), j = 511 - (int)(un >> 1), t0 = 32 * j; const size_t rb = (size_t)b * SEQ;
        bf16x8 qf[4][4];
        { const GAS bf16* qp = IQ + (rb + t0 + r32) * 256 + hi * 8;
#pragma unroll
          for (int h = 0; h < 4; ++h)
#pragma unroll
            for (int d0 = 0; d0 < 4; ++d0) qf[h][d0] = *(const GAS bf16x8*)(qp + h * 64 + d0 * 16); }
        const f32x4 wv = *(const GAS f32x4*)(IW + (rb + t0 + r32) * 4);
        if (tid < 32) { cnt[tid] = 0u; tau[tid] = -INFINITY; }
        if (tid < 4) flag[tid] = 0u;
        __syncthreads();
        const int ntiles = j + 1;
        const GAS bf16* kp = IK + (rb + r32) * 64 + hi * 8;
        bf16x8 kf[4];
        int it = wid; bool counted = false;
        if (it < ntiles) {
#pragma unroll
            for (int d0 = 0; d0 < 4; ++d0) kf[d0] = *(const GAS bf16x8*)(kp + (size_t)(32 * it) * 64 + d0 * 16); }
#pragma unroll 1
        for (;;) {
#pragma unroll 1
            while (it < ntiles) {
                if (__hip_atomic_load(flag, __ATOMIC_RELAXED, __HIP_MEMORY_SCOPE_WORKGROUP) != 0u) break;
                const int tile = it;
                float s[16];
#pragma unroll
                for (int h = 0; h < 4; ++h) { tk::f32x16 acc;
#pragma unroll
                    for (int r = 0; r < 16; ++r) acc[r] = 0.f;
#pragma unroll
                    for (int d0 = 0; d0 < 4; ++d0) acc = __builtin_amdgcn_mfma_f32_32x32x16_bf16(kf[d0], qf[h][d0], acc, 0, 0, 0);
#pragma unroll
                    for (int r = 0; r < 16; ++r) { const float af = acc[r]; const int ai = __builtin_bit_cast(int, af); const float rl = __builtin_bit_cast(float, ai > 0 ? ai : 0);
                        if (h == 0) asm volatile("v_fma_f32 %0, %1, %2, 0" : "=v"(s[r]) : "v"(wv[0]), "v"(rl));
                        else asm volatile("v_fma_f32 %0, %1, %2, %0" : "+v"(s[r]) : "v"(wv[h]), "v"(rl)); } }
                if (tile + 8 < ntiles) {
#pragma unroll
                    for (int d0 = 0; d0 < 4; ++d0) kf[d0] = *(const GAS bf16x8*)(kp + (size_t)(32 * (tile + 8)) * 64 + d0 * 16); }
                const float tq = tau[r32];
                if (tile == j) { int rl = r32, hl = hi; asm volatile("" : "+v"(rl), "+v"(hl));
#pragma unroll
                    for (int r = 0; r < 16; ++r) if (tk::crow(r, hl) > rl) s[r] = __builtin_nanf(""); }
                unsigned long long pm[16]; int np = 0;
#pragma unroll
                for (int r = 0; r < 16; ++r) { pm[r] = __ballot(s[r] >= tq); np += __builtin_amdgcn_inverse_ballot_w64(pm[r]) ? 1 : 0; }
                bool over = false;
                if (__any(np > 0)) {
                    unsigned pos = 0u;
                    if (np > 0) { pos = __hip_atomic_fetch_add(cnt + r32, (unsigned)np, __ATOMIC_RELAXED, __HIP_MEMORY_SCOPE_WORKGROUP); over = pos + (unsigned)np > 768u; }
                    const unsigned lpa = (unsigned)(uintptr_t)(list + r32 * tk::CAP);
                    const unsigned bb = 0xffffc000u | (unsigned)(0x3fe0 - 32 * tile) | (hi ? 0u : 4u);
#pragma unroll
                    for (int r = 0; r < 16; ++r) { const bool pass = __builtin_amdgcn_inverse_ballot_w64(pm[r]);
                        const unsigned ub = __builtin_bit_cast(unsigned, s[r]); const unsigned su = ub ^ ((unsigned)((int)ub >> 31) | 0x80000000u);
                        const unsigned cr = 0xffffc000u | (unsigned)(8 * (3 - (r >> 2)) + 3 - (r & 3)); const unsigned bc = bb & cr;
                        const unsigned comp = (su & bc) | ((bb | cr) & ~bc);
                        const unsigned addr = lpa + ((pos ^ (unsigned)r32) << 2);
                        unsigned long long keep;
                        asm volatile("s_mov_b64 %0, exec\n\ts_mov_b64 exec, %1\n\tds_write_b32 %2, %3\n\ts_mov_b64 exec, %0" : "=&s"(keep) : "s"(pm[r]), "v"(addr), "v"(comp) : "memory");
                        pos += pass ? 1u : 0u; }
                }
                it += 8;
                if (__any(over)) { if (lane == 0) __hip_atomic_store(flag, 1u, __ATOMIC_RELAXED, __HIP_MEMORY_SCOPE_WORKGROUP); break; }
            }
            if (it >= ntiles && !counted) { counted = true; if (lane == 0) __hip_atomic_fetch_add(flag + 1, 1u, __ATOMIC_RELAXED, __HIP_MEMORY_SCOPE_WORKGROUP); }
            asm volatile("s_waitcnt lgkmcnt(0)" ::: "memory");
            __syncthreads();
            const unsigned fcut = flag[0], ndone = flag[1];
            if (fcut != 0u) {
#pragma unroll 1
                for (int qi = 0; qi < 4; ++qi) { const int q = 4 * wid + qi; const int n = (int)cnt[q]; LAS unsigned* lp = list + q * tk::CAP;
                    if (n > NSEL) {
                        int ln = lane; asm volatile("" : "+v"(ln));
                        unsigned e[16];
                        { LAS const unsigned* lq = lp + (ln ^ q);
#pragma unroll
                        for (int i = 0; i < 16; ++i) { const unsigned x = lq[i * 64]; e[i] = (i * 64 + ln < n) ? x : 0u; } }
                        const unsigned tc = tk::select256(e, n, ln, hist, true);
                        int kc = 0;
#pragma unroll
                        for (int i = 0; i < 16; ++i) kc += (e[i] >= tc) ? 1 : 0;
                        const int incl_ = tk::dpp_scan_add(kc); int pos = incl_ - kc; const int kept = __builtin_amdgcn_readlane(incl_, 63);
                        asm volatile("s_waitcnt lgkmcnt(0)" ::: "memory");
#pragma unroll
                        for (int i = 0; i < 16; ++i) if (e[i] >= tc) { lp[pos ^ q] = e[i]; ++pos; }
                        if (ln == 0) { cnt[q] = (unsigned)kept; tau[q] = tk::unsortable(tc & 0xffffc000u); }
                    }
                }
                __syncthreads();
                if (tid == 0) flag[0] = 0u;
                __syncthreads();
            } else if (ndone == (unsigned)NWAVES) break;
        }
#pragma unroll 1
        for (int qi = 0; qi < 4; ++qi) { const int q = 4 * wid + qi; const int n = (int)cnt[q]; LAS unsigned* lp = list + q * tk::CAP;
            unsigned e[16];
            { LAS const unsigned* lq = lp + (lane ^ q);
#pragma unroll
            for (int i = 0; i < 16; ++i) { const unsigned x = lq[i * 64]; e[i] = (i * 64 + lane < n) ? x : 0u; } }
            const unsigned tc = tk::select256(e, n, lane, hist, false);
            asm volatile("s_waitcnt lgkmcnt(0)" ::: "memory");
#pragma unroll
            for (int i = 0; i < 8; ++i) lp[i * 64 + lane] = 0u;
            asm volatile("s_waitcnt lgkmcnt(0)" ::: "memory");
#pragma unroll
            for (int i = 0; i < 16; ++i) if (e[i] >= tc) { const unsigned idx = 0x3fffu - (e[i] & 0x3fffu);
                __hip_atomic_fetch_or(lp + (idx >> 5), 1u << (idx & 31u), __ATOMIC_RELAXED, __HIP_MEMORY_SCOPE_WORKGROUP); }
            asm volatile("s_waitcnt lgkmcnt(0)" ::: "memory");
            GAS unsigned* row = BM + (rb + t0 + q) * 512;
#pragma unroll
            for (int i = 0; i < 8; ++i) row[i * 64 + lane] = lp[i * 64 + lane];
        }
        __syncthreads();
        if (tid == 0) tick[0] = nxt;
        __syncthreads();
      }
}
__global__ void __launch_bounds__(NWAVES * 64, 2) fwd_kernel(Args args) {
    extern __shared__ __attribute__((aligned(16))) unsigned char lds[];
    Frame F;
    F.lds = (LAS unsigned char*)lds;
    F.MISC = (volatile LAS unsigned*)(F.lds + MISC_OFF);
    F.tid = threadIdx.x; F.lane = F.tid & 63; F.wave = __builtin_amdgcn_readfirstlane(F.tid >> 6);
    F.G = gridDim.x; F.ws = args.ws; F.out = args.out;
    F.ctl = (gu32*)(F.ws + WS_CTL);
    for (int u = F.tid; u < (LDS_BYTES - LDSCTL_OFF) / 4; u += NWAVES * 64) ((LAS unsigned*)(F.lds + LDSCTL_OFF))[u] = 0u;
    __syncthreads();
    XcdBarrier bar = xcd_barrier_post((unsigned*)(F.ctl + CW_BAR), F.MISC + 8, F.tid);
#define PHASE_TID() (F.wave * 64 + lane_id_now())
#define GRID_BAR() xcd_barrier(bar, PHASE_TID())
    LAS unsigned char* ring = F.lds + RING_OFF;
#define PHASE_WS() unsigned char* wsp = F.ws; asm volatile("" : "+s"(wsp))

    p0_prologue(F, args);
    GRID_BAR();
    p0b_quant(F, args);
    xquant_phase(F, 0);
    {
        PHASE_WS();
        pg8::Gemm g{(const bf16*)(wsp + WS_MEMB), (const bf16*)(wsp + WS_WKV), 512, DEPTH * 512, DM}; pg8::StaticOrder S; S.init(512, DEPTH * 512, F.G, (int)blockIdx.x);
        pg8::EpiMix<1> E{(const float*)(wsp + WS_SSM), (bf16*)(wsp + WS_MEMK), nullptr, (bf16*)(wsp + WS_MEMV), nullptr, nullptr, nullptr, nullptr, nullptr, nullptr, (const float*)(wsp + WS_GN) + 3 * DEPTH * 64, nullptr, 1.0f};
        pg8::gemm_phase<pg8::EpiMix<1>, pg8::StaticOrder, true, true>(ring, g, S, E, PHASE_TID());
    }
    GRID_BAR();
    for (int l = 0; l < DEPTH; ++l) {
        {
            PHASE_WS(); unsigned char* wl = wsp + WS_W + (size_t)l * WL_STRIDE;
            pg8::Gemm g{(const bf16*)(wsp + WS_XQ), (const bf16*)(wl + WL_1GU), T, NGU, DM / 2}; pg8::StaticOrder S; S.init(T, NGU, F.G, (int)blockIdx.x);
            pg8::EpiGLU8 E{(bf16*)(wsp + WS_ACT), (const float*)(wsp + WS_SSP), (const float*)(wsp + WS_SX), (const float*)(wsp + WS_SW) + ((size_t)l * 2 + 0) * NGU, DFF};
            pg8::gemm_phase<pg8::EpiGLU8, pg8::StaticOrder, true, true, true>(ring, g, S, E, PHASE_TID());
        }
        GRID_BAR();
        {
            PHASE_WS(); unsigned char* wl = wsp + WS_W + (size_t)l * WL_STRIDE;
            pg8::Gemm g{(const bf16*)(wsp + WS_ACT), (const bf16*)(wl + WL_1D), T, DM, DFF}; pg8::StaticOrder S; S.init(T, DM, F.G, (int)blockIdx.x);
            pg8::EpiRes E{nullptr, (bf16*)(wsp + WS_XB), (pg8::u64_t*)(wsp + WS_SSP) + (size_t)(3 * l + 1) * T, 0.5f};
            pg8::gemm_phase<pg8::EpiRes, pg8::StaticOrder, true, true>(ring, g, S, E, PHASE_TID());
        }
        GRID_BAR();
        {
            PHASE_WS(); unsigned char* wl = wsp + WS_W + (size_t)l * WL_STRIDE;
            pg8::Gemm g{(const bf16*)(wsp + WS_XB), (const bf16*)(wl + WL_IN), T, NIN, DM}; pg8::StaticOrder S; S.init(T, NIN, F.G, (int)blockIdx.x);
            pg8::EpiMix<0> E{(const pg8::u64_t*)(wsp + WS_SSP) + (size_t)(3 * l + 1) * T, (bf16*)(wsp + WS_AQ), (bf16*)(wsp + WS_AK), (bf16*)(wsp + WS_AV), (bf16*)(wsp + WS_IQ), (bf16*)(wsp + WS_PU), (bf16*)(wsp + WS_MQ), (bf16*)(wsp + WS_IK), (float*)(wsp + WS_IW),
                             (const float*)(wsp + WS_GN) + l * 64, (const float*)(wsp + WS_GN) + (DEPTH + l) * 64, (const float*)(wsp + WS_GN) + (2 * DEPTH + l) * 64, C2};
            pg8::gemm_phase<pg8::EpiMix<0>, pg8::StaticOrder, true, true>(ring, g, S, E, PHASE_TID());
        }
        GRID_BAR();
        topk_fast_phase(F, l);
        GRID_BAR();
        attn_dense_phase(F, l);
        pool_phase(F);
        GRID_BAR();
        {
            PHASE_WS(); unsigned char* wl = wsp + WS_W + (size_t)l * WL_STRIDE;
            pg8::Gemm g{(const bf16*)(wsp + WS_CAT), (const bf16*)(wl + WL_OUT), T, DM, DM}; pg8::StaticOrder S; S.init(T, DM, F.G, (int)blockIdx.x);
            pg8::EpiRes E{nullptr, (bf16*)(wsp + WS_XB), (pg8::u64_t*)(wsp + WS_SSP) + (size_t)(3 * l + 2) * T, 1.0f};
            pg8::gemm_phase<pg8::EpiRes, pg8::StaticOrder, true, true>(ring, g, S, E, PHASE_TID());
        }
        GRID_BAR();
        xquant_phase(F, 3 * l + 2);
        GRID_BAR();
        {
            PHASE_WS(); unsigned char* wl = wsp + WS_W + (size_t)l * WL_STRIDE;
            pg8::Gemm g{(const bf16*)(wsp + WS_XQ), (const bf16*)(wl + WL_2GU), T, NGU, DM / 2}; pg8::StaticOrder S; S.init(T, NGU, F.G, (int)blockIdx.x);
            pg8::EpiGLU8 E{(bf16*)(wsp + WS_ACT), (const float*)(wsp + WS_SSP), (const float*)(wsp + WS_SX), (const float*)(wsp + WS_SW) + ((size_t)l * 2 + 1) * NGU, DFF};
            pg8::gemm_phase<pg8::EpiGLU8, pg8::StaticOrder, true, true, true>(ring, g, S, E, PHASE_TID());
        }
        GRID_BAR();
        {
            PHASE_WS(); unsigned char* wl = wsp + WS_W + (size_t)l * WL_STRIDE;
            pg8::Gemm g{(const bf16*)(wsp + WS_ACT), (const bf16*)(wl + WL_2D), T, DM, DFF}; pg8::StaticOrder S; S.init(T, DM, F.G, (int)blockIdx.x);
            pg8::EpiRes E{(l == DEPTH - 1) ? F.out : nullptr, (bf16*)(wsp + WS_XB), (pg8::u64_t*)(wsp + WS_SSP) + (size_t)(3 * l + 3) * T, 0.5f};
            pg8::gemm_phase<pg8::EpiRes, pg8::StaticOrder, true, true>(ring, g, S, E, PHASE_TID());
        }
        if (l + 1 < DEPTH) { GRID_BAR(); xquant_phase(F, 3 * l + 3); GRID_BAR(); }
    }
}

extern "C" void kernel_launch(void* const* d_in, const int* in_sizes, int n_in, void* d_out, int out_size, void* d_ws, size_t ws_size, hipStream_t stream) {
    static int grid = 0;
    if (grid == 0) {
        if (n_in != 21 || out_size != T * DM || ws_size < WS_END) { fprintf(stderr, "kernel_launch: unexpected shapes (n_in %d, out %d, ws %zu)\n", n_in, out_size, ws_size); grid = -1; return; }
        int dev = 0, cus = 0, per_cu = 0;
        if (hipGetDevice(&dev) != hipSuccess || hipDeviceGetAttribute(&cus, hipDeviceAttributeMultiprocessorCount, dev) != hipSuccess) { grid = -1; return; }
        if (hipFuncSetAttribute((const void*)fwd_kernel, hipFuncAttributeMaxDynamicSharedMemorySize, LDS_BYTES) != hipSuccess) { fprintf(stderr, "kernel_launch: hipFuncSetAttribute failed\n"); grid = -1; return; }
        if (hipOccupancyMaxActiveBlocksPerMultiprocessor(&per_cu, (const void*)fwd_kernel, NWAVES * 64, LDS_BYTES) != hipSuccess || per_cu < 1) { fprintf(stderr, "kernel_launch: occupancy query says %d\n", per_cu); }
        (void)hipGetLastError();
        grid = cus;
    }
    if (grid < 0) return;
    if (hipMemsetAsync((char*)d_ws + WS_CTL, 0, CTL_ZERO_BYTES, stream) != hipSuccess) return;
    Args a{};
    for (int i = 0; i < 21; ++i) a.in[i] = (const float*)d_in[i];
    a.out = (float*)d_out; a.ws = (unsigned char*)d_ws;
    hipLaunchKernelGGL(fwd_kernel, dim3(grid), dim3(NWAVES * 64), LDS_BYTES, stream, a);
}
```

```cpp
#include <hip/hip_runtime.h>
#include <cstdio>
#include <cstdint>
namespace pg8 {
#define PG8_LAS __attribute__((address_space(3)))
typedef unsigned short bf16_t;
typedef short bf16x8 __attribute__((ext_vector_type(8)));
typedef float f32x4 __attribute__((ext_vector_type(4)));
typedef unsigned u32x4 __attribute__((ext_vector_type(4)));
constexpr int BM = 256, BK = 64, HALF = 128, HTB = HALF * BK * 2  , STAGE_BYTES = 8 * HTB, NXCD = 8, WGM = 8;

__host__ __device__ __forceinline__ int lds_byte(int r, int c) { const int st = (r >> 4) * 2 + (c >> 5), rr = r & 15, cc = c & 31, ob = rr * 64 + cc * 2; return st * 1024 + (ob ^ (((ob >> 9) & 1) << 5)); }
__host__ __device__ __forceinline__ void stage_rc(int b, int& R, int& C) { const int st = b / 1024, sb = b % 1024, swz = sb ^ (((sb >> 9) & 1) << 5); R = (st >> 1) * 16 + swz / 64; C = (st & 1) * 32 + (swz % 64) / 2; }
__host__ __device__ __forceinline__ int perm32(int rho) { const int n = rho >> 4, i = rho & 15; return 8 * (i >> 2) + 4 * n + (i & 3); }

struct Unit { int pm, pn; };
struct Gemm { const bf16_t* A; const bf16_t* Bt; int M, N, K; };

struct StaticOrder {
    int nM, nN, nwg, G, c;
    __host__ __device__ void init(int M, int N, int G_, int c_) { nM = M / BM; nN = N / BM; nwg = nM * nN; G = G_; c = c_; }
    __host__ __device__ bool next(int i, Unit& u) const {
        const long L = (long)i * G + c; if (L >= nwg) return false;
        int wgid = (int)L; { const int q = nwg / NXCD, r = nwg % NXCD, xcd = wgid % NXCD, off = wgid / NXCD; wgid = (xcd < r ? xcd * (q + 1) : r * (q + 1) + (xcd - r) * q) + off; }
        const int nig = WGM * nN, gid = wgid / nig, fm = gid * WGM, gsz = (nM - fm) < WGM ? (nM - fm) : WGM;
        u.pm = fm + ((wgid % nig) % gsz); u.pn = (wgid % nig) / gsz; return true;
    }
    __device__ __forceinline__ void a_ready(const Unit&) const {}
    __device__ __forceinline__ void done(const Unit&) const {}
};
__device__ __forceinline__ unsigned cvt_pk_bf16(float lo, float hi) { unsigned r; asm volatile("v_cvt_pk_bf16_f32 %0, %1, %2" : "=v"(r) : "v"(lo), "v"(hi)); return r; }
typedef int i32x4 __attribute__((ext_vector_type(4)));
typedef int i32x8 __attribute__((ext_vector_type(8)));
template <class Epi, class Sched, bool ALIGN_EPI = false, bool SP2 = false, int I8 = 0>
__device__ __forceinline__ void gemm_phase(PG8_LAS unsigned char* lds, const Gemm g, const Sched& S, const Epi& E, int tid_in) {
    int tid_ = tid_in; asm volatile("" : "+v"(tid_));
    const int tid = tid_, wid = __builtin_amdgcn_readfirstlane(tid >> 6), lane = tid & 63, wr = wid >> 2, wc = wid & 3, fr = lane & 15, fq = lane >> 4;
    const int K = g.K, nt = K / BK;
    unsigned voffA[2], voffB[2];
#pragma unroll
    for (int i = 0; i < 2; ++i) { int R, C; stage_rc(tid * 16 + i * 8192, R, C); const int Rb = Epi::PERM ? ((R & ~31) + perm32(R & 31)) : R;
        voffA[i] = (unsigned)(R * K + C) * 2u; voffB[i] = (unsigned)(Rb * K + C) * 2u; }
    const size_t uA_ = (size_t)((wid >> 1) * 2048 + (wid & 1) * 64), uB_ = (size_t)((((wid >> 1) * 16) & ~31) + 4 * ((wid >> 1) & 1)) * (size_t)(2 * K) + (size_t)((wid & 1) * 64);
    const size_t kstep = (size_t)(BK * 2);
    const size_t hstep = (size_t)HALF * K * 2;
    const size_t kstepA = (I8 == 2) ? (size_t)(BM * BK * 2) : kstep, hstepA = (I8 == 2) ? (size_t)(HALF * BK * 2) : hstep;
    const size_t tstep = 2 * hstep;
    const unsigned ldsb = (unsigned)__builtin_amdgcn_readfirstlane((int)(unsigned)(size_t)lds + wid * 1024);
    const unsigned ldsw = (unsigned)wid * 1024u;
    const int aoff = lds_byte(wr * 64 + fr, fq * 8), boff = lds_byte(wc * 32 + fr, fq * 8);
#define PG8_SA(b, h) (((b) * 2 + (h)) * HTB)
#define PG8_SB(b, h) ((4 + (b) * 2 + (h)) * HTB)
#define PG8_STAGE(bufoff, gbase, voff) do { _Pragma("unroll") for (int _i = 0; _i < 2; ++_i) { \
        if constexpr (I8 == 2) { unsigned keep_; unsigned z_ = 0u; asm volatile("" : "+v"(z_)); const unsigned ln_ = __builtin_amdgcn_mbcnt_hi(~0u, __builtin_amdgcn_mbcnt_lo(~0u, z_)); const bool isB_ = (&(voff)[0] == &voffB[0]); \
            const unsigned cp_ = ((ln_ & 3u) << 4) ^ ((ln_ >> 5) << 5); const unsigned vo_ = isB_ ? (((ln_ >> 4) << 3) | ((ln_ >> 2) & 3u)) * (unsigned)(2 * K) + cp_ : ((ln_ >> 2) << 7) + cp_; \
            const size_t d_ = (isB_ ? uB_ : uA_) + (_i ? (isB_ ? (size_t)(64 * 2) * (size_t)K : (size_t)(64 * BK * 2)) : (size_t)0); asm volatile("s_mov_b32 %0, m0\n\ts_mov_b32 m0, %3\n\ts_nop 0\n\tglobal_load_lds_dwordx4 %1, %2\n\ts_mov_b32 m0, %0" : "=&s"(keep_) : "v"(vo_), "s"((const char*)(gbase) + d_), "s"(ldsb + (unsigned)((bufoff) + _i * 8192)) : "memory"); } \
        else __builtin_amdgcn_global_load_lds((const unsigned*)((const char*)(gbase) + (voff)[_i]), (PG8_LAS unsigned*)(lds + (bufoff) + ldsw + _i * 8192), 16, 0, 0); } } while (0)
#define PG8_LDA(dst, b, h) do { _Pragma("unroll") for (int m = 0; m < 4; ++m) { if constexpr (I8 == 2) { dst##8[m].lo = *(const PG8_LAS i32x4*)(lds + PG8_SA(b, h) + aoff + m * 2048); dst##8[m].hi = *(const PG8_LAS i32x4*)(lds + PG8_SA(b, h) + aoff + m * 2048 + 1024); } \
        else { _Pragma("unroll") for (int k = 0; k < 2; ++k) dst[m][k] = *(const PG8_LAS bf16x8*)(lds + PG8_SA(b, h) + aoff + m * 2048 + k * 1024); } } } while (0)
#define PG8_LDB(dst, b, h) do { _Pragma("unroll") for (int n = 0; n < 2; ++n) { if constexpr (I8 == 2) { dst##8[n].lo = *(const PG8_LAS i32x4*)(lds + PG8_SB(b, h) + boff + n * 2048); dst##8[n].hi = *(const PG8_LAS i32x4*)(lds + PG8_SB(b, h) + boff + n * 2048 + 1024); } \
        else { _Pragma("unroll") for (int k = 0; k < 2; ++k) dst[n][k] = *(const PG8_LAS bf16x8*)(lds + PG8_SB(b, h) + boff + n * 2048 + k * 1024); } } } while (0)
#define PG8_MMA(ai, bj, At, Bt) do { __builtin_amdgcn_s_setprio(1); _Pragma("unroll") for (int m = 0; m < 4; ++m) _Pragma("unroll") for (int n = 0; n < 2; ++n) _Pragma("unroll") for (int k = 0; k < (I8 == 2 ? 1 : 2); ++k) \
        { if constexpr (I8 == 2) acc[ai][bj][m][n] = __builtin_bit_cast(AccT, __builtin_amdgcn_mfma_scale_f32_16x16x128_f8f6f4(Bt##8[n], At##8[m], __builtin_bit_cast(f32x4, acc[ai][bj][m][n]), 0, 0, 0, 0, 0, 0)); \
          else if constexpr (I8 == 1) acc[ai][bj][m][n] = __builtin_bit_cast(AccT, __builtin_amdgcn_mfma_i32_16x16x64_i8(__builtin_bit_cast(i32x4, Bt[n][k]), __builtin_bit_cast(i32x4, At[m][k]), __builtin_bit_cast(i32x4, acc[ai][bj][m][n]), 0, 0, 0)); \
          else acc[ai][bj][m][n] = __builtin_bit_cast(AccT, __builtin_amdgcn_mfma_f32_16x16x32_bf16(Bt[n][k], At[m][k], __builtin_bit_cast(f32x4, acc[ai][bj][m][n]), 0, 0, 0)); } __builtin_amdgcn_s_setprio(0); } while (0)
#define PG8_WAIT_V(n) asm volatile("s_waitcnt vmcnt(" #n ")" ::: "memory")
#define PG8_WAIT_L(n) asm volatile("s_waitcnt lgkmcnt(" #n ")" ::: "memory")
#define PG8_BAR __builtin_amdgcn_s_barrier()
#define PG8_SCHED __builtin_amdgcn_sched_barrier(0)
    Unit cur, nxt; int ui = 0;
    if (!S.next(0, cur)) return;
    typedef typename Epi::AccT AccT;
    AccT acc[2][2][4][2];
#pragma unroll
    for (int a = 0; a < 2; ++a)
#pragma unroll
        for (int b = 0; b < 2; ++b)
#pragma unroll
            for (int m = 0; m < 4; ++m)
#pragma unroll
                for (int n = 0; n < 2; ++n) acc[a][b][m][n] = AccT{};
    bf16x8 At[4][2], B0[2][2], B1[2][2];
    i32x8 At8[4], B08[2], B18[2];
    const char* cA = (const char*)g.A + (size_t)cur.pm * tstep; const char* cB = (const char*)g.Bt + (size_t)cur.pn * tstep;
    S.a_ready(cur);
    if constexpr (SP2) {
        PG8_STAGE(PG8_SB(0, 0), cB, voffB); PG8_STAGE(PG8_SB(0, 1), cB + hstep, voffB); PG8_STAGE(PG8_SA(0, 0), cA, voffA); PG8_STAGE(PG8_SA(0, 1), cA + hstepA, voffA);
        if (wr == 1) PG8_BAR;
        PG8_WAIT_V(2); PG8_BAR;
        PG8_STAGE(PG8_SB(1, 0), cB + kstep, voffB); PG8_STAGE(PG8_SA(1, 0), cA + kstepA, voffA); PG8_STAGE(PG8_SB(1, 1), cB + hstep + kstep, voffB);
        PG8_WAIT_V(6); PG8_BAR;
    } else {
        PG8_STAGE(PG8_SB(0, 0), cB, voffB); PG8_STAGE(PG8_SA(0, 0), cA, voffA); PG8_STAGE(PG8_SB(0, 1), cB + hstep, voffB); PG8_STAGE(PG8_SA(0, 1), cA + hstepA, voffA);
        if (wr == 1) PG8_BAR;
        PG8_WAIT_V(4); PG8_BAR;
        PG8_STAGE(PG8_SB(1, 0), cB + kstep, voffB); PG8_STAGE(PG8_SA(1, 0), cA + kstepA, voffA); PG8_STAGE(PG8_SB(1, 1), cB + hstep + kstep, voffB);
        PG8_WAIT_V(6); PG8_BAR;
    }
    for (;;) {
        const bool has_next = S.next(ui + 1, nxt);
        const char* nA = has_next ? (const char*)g.A + (size_t)nxt.pm * tstep : cA; const char* nB = has_next ? (const char*)g.Bt + (size_t)nxt.pn * tstep : cB;
        for (int t = 0; t < nt; t += 2) {
            const bool last = (t == nt - 2);
            const char* a1 = cA + (size_t)(t + 1) * kstepA;
            const char* a2 = last ? nA : cA + (size_t)(t + 2) * kstepA; const char* b2 = last ? nB : cB + (size_t)(t + 2) * kstep;
            const char* a3 = a2 + kstepA; const char* b3 = b2 + kstep;
            if (last && has_next) S.a_ready(nxt);
            if constexpr (SP2) {
            PG8_LDB(B0, 0, 0); PG8_LDB(B1, 0, 1); PG8_SCHED; PG8_LDA(At, 0, 0); PG8_STAGE(PG8_SA(1, 1), a1 + hstepA, voffA);
            PG8_WAIT_V(8); PG8_WAIT_L(0); PG8_BAR; PG8_MMA(0, 0, At, B0); PG8_MMA(0, 1, At, B1); PG8_BAR; PG8_SCHED;
            PG8_LDA(At, 0, 1); PG8_STAGE(PG8_SB(0, 0), b2, voffB); PG8_STAGE(PG8_SB(0, 1), b2 + hstep, voffB); PG8_STAGE(PG8_SA(0, 0), a2, voffA);
            PG8_WAIT_V(8); PG8_WAIT_L(0); PG8_BAR; PG8_MMA(1, 0, At, B0); PG8_MMA(1, 1, At, B1); PG8_BAR; PG8_SCHED;
            PG8_LDB(B0, 1, 0); PG8_LDB(B1, 1, 1); PG8_SCHED; PG8_LDA(At, 1, 0); PG8_STAGE(PG8_SA(0, 1), a2 + hstepA, voffA);
            PG8_WAIT_V(8); PG8_WAIT_L(0); PG8_BAR; PG8_MMA(0, 0, At, B0); PG8_MMA(0, 1, At, B1); PG8_BAR; PG8_SCHED;
            PG8_LDA(At, 1, 1); PG8_STAGE(PG8_SB(1, 0), b3, voffB); PG8_STAGE(PG8_SB(1, 1), b3 + hstep, voffB); PG8_STAGE(PG8_SA(1, 0), a3, voffA);
            PG8_WAIT_V(8); PG8_WAIT_L(0); PG8_BAR; PG8_MMA(1, 0, At, B0); PG8_MMA(1, 1, At, B1); PG8_BAR; PG8_SCHED;
            } else {
            PG8_LDB(B0, 0, 0); PG8_SCHED; PG8_LDA(At, 0, 0); PG8_STAGE(PG8_SA(1, 1), a1 + hstepA, voffA);
            PG8_WAIT_L(8); PG8_BAR; PG8_WAIT_L(0); PG8_MMA(0, 0, At, B0); PG8_BAR; PG8_SCHED;
            PG8_LDB(B1, 0, 1); PG8_STAGE(PG8_SB(0, 0), b2, voffB);
            PG8_BAR; PG8_WAIT_L(0); PG8_MMA(0, 1, At, B1); PG8_BAR;
            PG8_LDA(At, 0, 1); PG8_STAGE(PG8_SA(0, 0), a2, voffA);
            PG8_BAR; PG8_WAIT_L(0); PG8_MMA(1, 0, At, B0); PG8_BAR; PG8_SCHED;
            PG8_STAGE(PG8_SB(0, 1), b2 + hstep, voffB);
            PG8_WAIT_V(6); PG8_BAR; PG8_MMA(1, 1, At, B1); PG8_BAR;
            PG8_LDB(B0, 1, 0); PG8_SCHED; PG8_LDA(At, 1, 0); PG8_STAGE(PG8_SA(0, 1), a2 + hstepA, voffA);
            PG8_WAIT_L(8); PG8_BAR; PG8_WAIT_L(0); PG8_MMA(0, 0, At, B0); PG8_BAR; PG8_SCHED;
            PG8_LDB(B1, 1, 1); PG8_STAGE(PG8_SB(1, 0), b3, voffB);
            PG8_BAR; PG8_WAIT_L(0); PG8_MMA(0, 1, At, B1); PG8_BAR;
            PG8_LDA(At, 1, 1); PG8_STAGE(PG8_SA(1, 0), a3, voffA);
            PG8_BAR; PG8_WAIT_L(0); PG8_MMA(1, 0, At, B0); PG8_BAR; PG8_SCHED;
            PG8_STAGE(PG8_SB(1, 1), b3 + hstep, voffB);
            PG8_WAIT_V(6); PG8_BAR; PG8_MMA(1, 1, At, B1); PG8_BAR;
            }
        }
        if constexpr (ALIGN_EPI) { if (wr == 0) PG8_BAR; }
        if constexpr (!Epi::AFTER_DRAIN) { E(acc, cur, wr, wc, fr, fq); S.done(cur); }
        if (!has_next) break;
#pragma unroll
        for (int a = 0; a < 2; ++a)
#pragma unroll
            for (int b = 0; b < 2; ++b)
#pragma unroll
                for (int m = 0; m < 4; ++m)
#pragma unroll
                    for (int n = 0; n < 2; ++n) acc[a][b][m][n] = AccT{};
        cur = nxt; cA = nA; cB = nB; ++ui;
        if constexpr (ALIGN_EPI) { if (wr == 1) PG8_BAR; }
    }
    PG8_WAIT_V(0);
    if constexpr (!ALIGN_EPI) { if (wr == 0) PG8_BAR; }
    PG8_BAR;
    if constexpr (Epi::AFTER_DRAIN) { E.fused(acc, cur, wr, wc, fr, fq, lds, wid, lane); S.done(cur); }
#undef PG8_SA
#undef PG8_SB
#undef PG8_STAGE
#undef PG8_LDA
#undef PG8_LDB
#undef PG8_MMA
#undef PG8_WAIT_V
#undef PG8_WAIT_L
#undef PG8_BAR
#undef PG8_SCHED
}
}
namespace pg8 {
constexpr float NORM_EPS = 1e-6f;
typedef unsigned long long u64_t;
constexpr float SS_FIX = 1048576.0f;
__device__ __forceinline__ float ss_val(u64_t v) { return (float)v * (1.0f / SS_FIX); }
__device__ __forceinline__ float ss_val_fast(u64_t v) { return ((float)(unsigned)(v >> 32) * 4294967296.0f + (float)(unsigned)v) * (1.0f / SS_FIX); }
__device__ __forceinline__ float row_rstd(const float* ss, int row) { return __builtin_amdgcn_rsqf(ss[row] * (1.0f / 1024.0f) + NORM_EPS); }
__device__ __forceinline__ float silu_mul(float g, float u) { return g * __builtin_amdgcn_rcpf(1.0f + __builtin_amdgcn_exp2f(-1.4426950408889634f * g)) * u; }

constexpr float H8_SCALE = 8.0f;
typedef unsigned u32x2_ __attribute__((ext_vector_type(2)));
struct EpiGLU8 {
    typedef i32x4 AccT;
    static constexpr bool PERM = true, AFTER_DRAIN = false;
    bf16_t* act; const float* ssp; const float* sx; const float* sw; int ldc;
    __device__ __forceinline__ void operator()(const i32x4 (&acc)[2][2][4][2], const Unit& u, int wr, int wc, int fr, int fq) const {
        const int row0 = u.pm * BM + wr * 64 + fr, col0 = u.pn * 128 + wc * 32 + 8 * fq;
        const float* swp = sw + u.pn * 256 + wc * 32 + 8 * fq;
        const f32x4 sg0 = *(const f32x4*)swp, sg1 = *(const f32x4*)(swp + 4), su0 = *(const f32x4*)(swp + 128), su1 = *(const f32x4*)(swp + 132);
        const f32x4 sl0 = sg0 * -1.4426950408889634f, sl1 = sg1 * -1.4426950408889634f, sp0 = sg0 * su0 * H8_SCALE, sp1 = sg1 * su1 * H8_SCALE;
        __builtin_amdgcn_s_setreg(1 | (23 << 6), 1);
        float rsv[2][4];
#pragma unroll
        for (int ai = 0; ai < 2; ++ai)
#pragma unroll
            for (int m = 0; m < 4; ++m) rsv[ai][m] = sx[row0 + ai * HALF + m * 16];
#pragma unroll
        for (int ai = 0; ai < 2; ++ai)
#pragma unroll
            for (int m = 0; m < 4; ++m) { const int row = row0 + ai * HALF + m * 16; const float rs = rsv[ai][m];
                const f32x4 rr = {rs, rs, rs, rs};
                f32x4 a0, a1, b0, b1;
#pragma unroll
                for (int e = 0; e < 4; ++e) { a0[e] = (float)acc[ai][0][m][0][e]; a1[e] = (float)acc[ai][0][m][1][e]; b0[e] = (float)acc[ai][1][m][0][e]; b1[e] = (float)acc[ai][1][m][1][e]; }
                a0 = a0 * rr; a1 = a1 * rr; b0 = b0 * rr; b1 = b1 * rr;
                const f32x4 t0 = a0 * sl0, t1 = a1 * sl1;
                f32x4 d0, d1;
#pragma unroll
                for (int e = 0; e < 4; ++e) { d0[e] = __builtin_amdgcn_exp2f(t0[e]); d1[e] = __builtin_amdgcn_exp2f(t1[e]); }
                d0 = d0 + 1.0f; d1 = d1 + 1.0f;
#pragma unroll
                for (int e = 0; e < 4; ++e) { d0[e] = __builtin_amdgcn_rcpf(d0[e]); d1[e] = __builtin_amdgcn_rcpf(d1[e]); }
                const f32x4 h0 = (a0 * b0) * (sp0 * d0), h1 = (a1 * b1) * (sp1 * d1);
                int p0 = __builtin_amdgcn_cvt_pk_fp8_f32(h0[0], h0[1], 0, false); p0 = __builtin_amdgcn_cvt_pk_fp8_f32(h0[2], h0[3], p0, true);
                int p1 = __builtin_amdgcn_cvt_pk_fp8_f32(h1[0], h1[1], 0, false); p1 = __builtin_amdgcn_cvt_pk_fp8_f32(h1[2], h1[3], p1, true);
                u32x2_ w; w.x = (unsigned)p0; w.y = (unsigned)p1;
                *(u32x2_*)((unsigned char*)act + (size_t)u.pm * ((size_t)ldc * BM) + (size_t)u.pn * (BM * 128) + (size_t)(row & (BM - 1)) * 128 + (wc * 32 + 8 * fq)) = w;   asm volatile("" ::: "memory"); }
    }
};
template <bool SC>
struct EpiResT {
    typedef f32x4 AccT;
    static constexpr bool PERM = true, AFTER_DRAIN = false;
    float* xout; bf16_t* xb; u64_t* ssn; float alpha; const float* csc;
    __device__ __forceinline__ void operator()(const f32x4 (&acc)[2][2][4][2], const Unit& u, int wr, int wc, int fr, int fq) const {
        const int row0 = u.pm * BM + wr * 64 + fr, col0 = u.pn * BM + wc * 32 + 8 * fq;
        f32x4 al[2][2];
#pragma unroll
        for (int bj = 0; bj < 2; ++bj) { if constexpr (SC) { al[bj][0] = *(const f32x4*)(csc + col0 + bj * HALF) * alpha; al[bj][1] = *(const f32x4*)(csc + col0 + bj * HALF + 4) * alpha; } else { al[bj][0] = (f32x4){alpha, alpha, alpha, alpha}; al[bj][1] = al[bj][0]; } }
#pragma unroll
        for (int ai = 0; ai < 2; ++ai) {
            u32x4 xo[4][2];
#pragma unroll
            for (int m = 0; m < 4; ++m)
#pragma unroll
                for (int bj = 0; bj < 2; ++bj) xo[m][bj] = *(const u32x4*)(xb + (size_t)(row0 + ai * HALF + m * 16) * 1024 + col0 + bj * HALF);
#pragma unroll
            for (int m = 0; m < 4; ++m) { const int row = row0 + ai * HALF + m * 16; float q = 0.f;
#pragma unroll
                for (int bj = 0; bj < 2; ++bj) { const u32x4 xw = xo[m][bj];
                    f32x4 a, b;
                    a[0] = __builtin_bit_cast(float, xw.x << 16); a[1] = __builtin_bit_cast(float, xw.x & 0xffff0000u); a[2] = __builtin_bit_cast(float, xw.y << 16); a[3] = __builtin_bit_cast(float, xw.y & 0xffff0000u);
                    b[0] = __builtin_bit_cast(float, xw.z << 16); b[1] = __builtin_bit_cast(float, xw.z & 0xffff0000u); b[2] = __builtin_bit_cast(float, xw.w << 16); b[3] = __builtin_bit_cast(float, xw.w & 0xffff0000u);
                    a = a + acc[ai][bj][m][0] * al[bj][0]; b = b + acc[ai][bj][m][1] * al[bj][1];
                    if (xout) { float* p = xout + (size_t)row * 1024 + col0 + bj * HALF; *(f32x4*)p = a; *(f32x4*)(p + 4) = b; }
                    if (xout) continue;
                    u32x4 w; w.x = cvt_pk_bf16(a[0], a[1]); w.y = cvt_pk_bf16(a[2], a[3]); w.z = cvt_pk_bf16(b[0], b[1]); w.w = cvt_pk_bf16(b[2], b[3]);
                    const float r0 = __builtin_bit_cast(float, w.x << 16), r1 = __builtin_bit_cast(float, w.x & 0xffff0000u), r2 = __builtin_bit_cast(float, w.y << 16), r3 = __builtin_bit_cast(float, w.y & 0xffff0000u);
                    const float r4 = __builtin_bit_cast(float, w.z << 16), r5 = __builtin_bit_cast(float, w.z & 0xffff0000u), r6 = __builtin_bit_cast(float, w.w << 16), r7 = __builtin_bit_cast(float, w.w & 0xffff0000u);
                    q += ((r0 * r0 + r1 * r1) + (r2 * r2 + r3 * r3)) + ((r4 * r4 + r5 * r5) + (r6 * r6 + r7 * r7));
                    *(u32x4*)(xb + (size_t)row * 1024 + col0 + bj * HALF) = w; }
                q += __shfl_xor(q, 16); q += __shfl_xor(q, 32);
                if (fq == 0 && !xout) __hip_atomic_fetch_add(ssn + row, (u64_t)(q * SS_FIX), __ATOMIC_RELAXED, __HIP_MEMORY_SCOPE_AGENT); }
            asm volatile("" ::: "memory"); }
    }
};
template <int MODE> struct EpiMix {
    typedef f32x4 AccT;
    static constexpr bool PERM = true, AFTER_DRAIN = false;
    const void* ssp;
    bf16_t *aq, *ak, *av, *iq, *pu, *mq, *ik; float* iw;
    const float *gq, *gk, *gmq;
    float c2;
    __device__ __forceinline__ void operator()(const f32x4 (&acc)[2][2][4][2], const Unit& u, int wr, int wc, int fr, int fq) const {
        const int row0 = u.pm * BM + wr * 64 + fr, pn = u.pn;
        if (MODE == 0) __builtin_amdgcn_s_setreg(1 | (23 << 6), 1);
        bf16_t* base; int pitch, kind; const float* g = gk; float sc = 1.0f;
        if (MODE == 1) { const int layer = pn >> 1; kind = pn & 1; base = ((pn & 1) ? av : aq) + (size_t)layer * 512 * 256; pitch = 256; g = gk + layer * 64; }
        else if (pn < 2) { base = aq + pn * 128; pitch = 256; kind = 0; g = gq; sc = __builtin_sqrtf(c2); }
        else if (pn < 4) { base = ak + (pn - 2) * 128; pitch = 256; kind = 0; g = gk; sc = __builtin_sqrtf(c2); }
        else if (pn < 6) { base = av + (pn - 4) * 256; pitch = 512; kind = 1; }
        else if (pn == 6) { base = iq; pitch = 256; kind = 2; }
        else if (pn == 7) { base = pu; pitch = 256; kind = 2; }
        else if (pn == 8) { base = mq; pitch = 256; kind = 0; g = gmq; sc = c2; }
        else { base = ik; pitch = 64; kind = 3; }
        const int co0 = (kind == 2) ? wc * 32 + 8 * fq : wc * 64 + 8 * fq, co1 = (kind == 2) ? co0 + HALF : co0 + 32;
        float ssv[2][4];
#pragma unroll
        for (int ai = 0; ai < 2; ++ai)
#pragma unroll
            for (int m = 0; m < 4; ++m) { const int rr = row0 + ai * HALF + m * 16; ssv[ai][m] = (MODE == 1) ? ((const float*)ssp)[rr] : ss_val_fast(((const u64_t*)ssp)[rr]); }
        f32x4 gv[2][2];
#pragma unroll
        for (int bj = 0; bj < 2; ++bj)
#pragma unroll
            for (int n = 0; n < 2; ++n) gv[bj][n] = (kind == 0) ? *(const f32x4*)(g + bj * 32 + 8 * fq + 4 * n) * sc : (f32x4){1.f, 1.f, 1.f, 1.f};
#pragma unroll
        for (int ai = 0; ai < 2; ++ai)
#pragma unroll
            for (int m = 0; m < 4; ++m) { const int row = row0 + ai * HALF + m * 16; const float rs = __builtin_amdgcn_rsqf(ssv[ai][m] * (1.0f / 1024.0f) + NORM_EPS);
                if (kind == 3) {
                    if (wc < 2) { const f32x4 a = acc[ai][0][m][0] * rs, b = acc[ai][0][m][1] * rs;
                        u32x4 w; w.x = cvt_pk_bf16(a[0], a[1]); w.y = cvt_pk_bf16(a[2], a[3]); w.z = cvt_pk_bf16(b[0], b[1]); w.w = cvt_pk_bf16(b[2], b[3]);
                        *(u32x4*)(base + (size_t)row * 64 + wc * 32 + 8 * fq) = w; }
                    else if (wc == 2 && fq == 0) { *(f32x4*)(iw + (size_t)row * 4) = acc[ai][0][m][0] * rs; }
                } else {
                    f32x4 v[2][2];
#pragma unroll
                    for (int bj = 0; bj < 2; ++bj)
#pragma unroll
                        for (int n = 0; n < 2; ++n) v[bj][n] = acc[ai][bj][m][n] * rs;
                    float r = 1.0f;
                    if (kind == 0) { float s = 0.f;
#pragma unroll
                        for (int bj = 0; bj < 2; ++bj)
#pragma unroll
                            for (int n = 0; n < 2; ++n) s += (v[bj][n][0] * v[bj][n][0] + v[bj][n][1] * v[bj][n][1]) + (v[bj][n][2] * v[bj][n][2] + v[bj][n][3] * v[bj][n][3]);
                        s += __shfl_xor(s, 16); s += __shfl_xor(s, 32);
                        r = __builtin_amdgcn_rsqf(s * (1.0f / 64.0f) + NORM_EPS); }
                    bf16_t* rp = base + (size_t)row * pitch;
                    unsigned char* vt = (unsigned char*)av + ((size_t)((row >> 14) * 8 + (pn - 4) * 4 + wc) * 64 + 8 * fq) * 16384 + (row & 16383);
#pragma unroll
                    for (int bj = 0; bj < 2; ++bj) { const f32x4 a = v[bj][0] * gv[bj][0] * r, b = v[bj][1] * gv[bj][1] * r;
                        u32x4 w; w.x = cvt_pk_bf16(a[0], a[1]); w.y = cvt_pk_bf16(a[2], a[3]); w.z = cvt_pk_bf16(b[0], b[1]); w.w = cvt_pk_bf16(b[2], b[3]);
                        if (MODE == 0 && pn < 4) {
                            int p0 = __builtin_amdgcn_cvt_pk_fp8_f32(a[0], a[1], 0, false); p0 = __builtin_amdgcn_cvt_pk_fp8_f32(a[2], a[3], p0, true);
                            int p1 = __builtin_amdgcn_cvt_pk_fp8_f32(b[0], b[1], 0, false); p1 = __builtin_amdgcn_cvt_pk_fp8_f32(b[2], b[3], p1, true);
                            typedef unsigned u32x2_ __attribute__((ext_vector_type(2)));
                            *(u32x2_*)((unsigned char*)rp + wc * 64 + 32 * bj + 8 * fq) = (u32x2_){(unsigned)p0, (unsigned)p1}; }
                        else if (MODE == 0 && kind == 1) { unsigned char* vp = vt + (size_t)(32 * bj) * 16384;
                            int p0 = __builtin_amdgcn_cvt_pk_fp8_f32(a[0], a[1], 0, false); p0 = __builtin_amdgcn_cvt_pk_fp8_f32(a[2], a[3], p0, true);
                            int p1 = __builtin_amdgcn_cvt_pk_fp8_f32(b[0], b[1], 0, false); p1 = __builtin_amdgcn_cvt_pk_fp8_f32(b[2], b[3], p1, true);
                            vp[0 * 16384] = (unsigned char)p0; vp[1 * 16384] = (unsigned char)(p0 >> 8); vp[2 * 16384] = (unsigned char)(p0 >> 16); vp[3 * 16384] = (unsigned char)(p0 >> 24);
                            vp[4 * 16384] = (unsigned char)p1; vp[5 * 16384] = (unsigned char)(p1 >> 8); vp[6 * 16384] = (unsigned char)(p1 >> 16); vp[7 * 16384] = (unsigned char)(p1 >> 24); }
                        else *(u32x4*)(rp + (bj ? co1 : co0)) = w; }
                }
                asm volatile("" ::: "memory");
            }
    }
};
}
constexpr int NWAVES = 8;
constexpr int BATCH = 2, SEQ = 16384, DM = 1024, DEPTH = 4, T = BATCH * SEQ;
constexpr int DFF = 2816, NGU = 2 * DFF, DIN = 2372, NIN = 2560, NMEM = 256, NSEL = 256;
constexpr float C2 = 0.125f * 1.4426950408889634f;
constexpr size_t MiB = 1u << 20;
constexpr size_t WS_CTL = 0, CTL_ZERO_BYTES = 4 * MiB + 512 * 1024;
constexpr size_t WS_SSP = 1 * MiB;
constexpr size_t WS_SSM = 4 * MiB + 512 * 1024;
constexpr size_t WS_GN = 4 * MiB + 512 * 1024 + 48 * 1024;
constexpr size_t WS_MEMB = 4 * MiB + 512 * 1024 + 64 * 1024;
constexpr size_t WS_WKV = 6 * MiB;
constexpr size_t WS_MEMK = 10 * MiB, WS_MEMV = 11 * MiB;
constexpr size_t WS_SW = 5 * MiB + 768 * 1024;
constexpr size_t WS_CMXD = 448 * 1024;
constexpr size_t WS_SWD = 5 * MiB + 960 * 1024;
constexpr size_t WS_TKQ = 128 * 1024;
constexpr size_t WS_CMX = 256 * 1024;
constexpr size_t WS_W = 12 * MiB;
constexpr size_t WL_1GU = 0, WL_1D = 11 * MiB, WL_IN = 11 * MiB + 5632 * 1024, WL_OUT = WL_IN + 5 * MiB, WL_2GU = WL_OUT + 2 * MiB, WL_2D = WL_2GU + 11 * MiB, WL_STRIDE = 40 * MiB;
static_assert(WL_2D + (size_t)DM * DFF * 2 <= WL_STRIDE, "layer weights");
constexpr size_t WS_XB = 172 * MiB;
constexpr size_t WS_CAT = 236 * MiB;
constexpr size_t WS_XQ = WS_CAT, WS_SX = WS_CAT + 32 * MiB;
constexpr size_t WS_ACT = 300 * MiB;
constexpr size_t WS_AQ = WS_ACT, WS_AK = WS_AQ + 32 * MiB, WS_AV = WS_AK + 32 * MiB, WS_IQ = WS_AV + 32 * MiB, WS_PU = WS_IQ + 16 * MiB, WS_MQ = WS_PU + 16 * MiB, WS_IK = WS_MQ + 16 * MiB, WS_IW = WS_IK + 4 * MiB;
constexpr size_t WS_END = WS_ACT + 176 * MiB;
static_assert(WS_IW + (size_t)T * 16 <= WS_END && WS_END <= 512 * MiB, "d_ws map");
constexpr int CW_BAR = 4096;
constexpr int RING_OFF = 0, RING_BYTES = 131072;
constexpr int LDSCTL_OFF = RING_BYTES, MISC_OFF = LDSCTL_OFF + 320;
constexpr int LDS_BYTES = 147456;
static_assert(MISC_OFF + 128 <= LDS_BYTES, "LDS map");
#define GAS __attribute__((address_space(1)))
#define LAS __attribute__((address_space(3)))
typedef unsigned short bf16;
typedef unsigned v4u __attribute__((ext_vector_type(4)));
typedef float f32x4 __attribute__((ext_vector_type(4)));
typedef short bf16x8 __attribute__((ext_vector_type(8)));
typedef GAS unsigned gu32;
typedef GAS unsigned long long gu64;
#define RLX_AGENT __ATOMIC_RELAXED, __HIP_MEMORY_SCOPE_AGENT
#define LDS_WAIT() asm volatile("s_waitcnt lgkmcnt(0)" ::: "memory")
#define VM_WAIT() asm volatile("s_waitcnt vmcnt(0)" ::: "memory")
__device__ __forceinline__ unsigned long long rt() { return __builtin_amdgcn_s_memrealtime(); }
__device__ __forceinline__ unsigned f2bf(float f) { unsigned u = __builtin_bit_cast(unsigned, f); return (u + 0x7fffu + ((u >> 16) & 1u)) >> 16; }
__device__ __forceinline__ unsigned pk2(float lo, float hi) { return f2bf(lo) | (f2bf(hi) << 16); }

#define XB_TMO      128
#define XB_XCNT(j)  (256  + 64 * (j))
#define XB_XSUB(j)  (1280 + 64 * (j))
#define XB_XGEN(j)  (2304 + 64 * (j))
#define XB_TOP      3328
#define XB_TOPGEN   3392
#define XCD_BAR_WORDS 3456
#define XB_SPIN_CAP (1u << 18)

__device__ __forceinline__ unsigned xb_ld(unsigned* p)              { return __hip_atomic_load(p, __ATOMIC_RELAXED, __HIP_MEMORY_SCOPE_AGENT); }
__device__ __forceinline__ unsigned xb_add(unsigned* p, unsigned v) { return __hip_atomic_fetch_add(p, v, __ATOMIC_RELAXED, __HIP_MEMORY_SCOPE_AGENT); }
__device__ __forceinline__ unsigned xb_xcc_id() { return (unsigned)__builtin_amdgcn_s_getreg((3 << 11) | 20) & 0xFu; }
#define XB_SPIN(cond, bar) do { unsigned _sp = 0; while (cond) { __builtin_amdgcn_s_sleep(1); \
    if ((++_sp & 255u) == 0u) { if (xb_ld(&(bar)[XB_TMO])) break; if (_sp > XB_SPIN_CAP) { atomicAdd(&(bar)[XB_TMO], 1u); break; } } } } while (0)

struct XcdBarrier {
    unsigned* bar; unsigned x;
    volatile LAS unsigned* st;
};

__device__ __forceinline__ XcdBarrier xcd_barrier_post(unsigned* bar, volatile LAS unsigned* st, int tid) {
    XcdBarrier b; b.bar = bar; b.x = xb_xcc_id(); b.st = st;
    if (tid == 0) (void)xb_add(&bar[XB_XCNT(b.x)], 1u);
    return b;
}
__device__ __forceinline__ void xcd_barrier_complete(unsigned* bar, unsigned x, unsigned& nloc, unsigned& nx) {
    const unsigned G = gridDim.x * gridDim.y * gridDim.z;
    unsigned sum, cnt, mine, sp = 0u;
    for (;;) {
        sum = 0u; cnt = 0u; mine = 0u;
#pragma unroll
        for (unsigned j = 0; j < 16; ++j) { const unsigned c = xb_ld(&bar[XB_XCNT(j)]); sum += c; cnt += (c > 0u) ? 1u : 0u; mine = (j == x) ? c : mine; }
        if (sum == G) break;
        __builtin_amdgcn_s_sleep(1);
        if ((++sp & 255u) == 0u) { if (xb_ld(&bar[XB_TMO])) break; if (sp > XB_SPIN_CAP) { atomicAdd(&bar[XB_TMO], 1u); break; } }
    }
    nloc = mine > 0u ? mine : 1u; nx = cnt > 0u ? cnt : 1u;
}

__device__ __forceinline__ void xcd_barrier(const XcdBarrier& b, int tid) {
    asm volatile("s_waitcnt vmcnt(0)" ::: "memory");
    __syncthreads();
    if (tid == 0) {
        unsigned bx = xb_xcc_id(); asm volatile("" : "+s"(bx));
        unsigned* bar = b.bar; asm volatile("" : "+s"(bar));
        __builtin_amdgcn_s_waitcnt(0);
        unsigned nloc = b.st[0], nx = b.st[1];
        if (nloc == 0u) { xcd_barrier_complete(bar, bx, nloc, nx); b.st[0] = nloc; b.st[1] = nx; }
        const unsigned old = xb_add(&bar[XB_XSUB(bx)], 1u);
        const unsigned gen = old / nloc;
        if (old + 1u == (gen + 1u) * nloc) {
            __builtin_amdgcn_fence(__ATOMIC_RELEASE, "agent");
            asm volatile("s_waitcnt vmcnt(0)" ::: "memory");
            const unsigned og = xb_add(&bar[XB_TOP], 1u);
            const unsigned tg = og / nx;
            if (og + 1u == (tg + 1u) * nx) xb_add(&bar[XB_TOPGEN], 1u);
            else XB_SPIN(xb_ld(&bar[XB_TOPGEN]) == tg, bar);
            __builtin_amdgcn_fence(__ATOMIC_ACQUIRE, "agent");
            xb_add(&bar[XB_XGEN(bx)], 1u);
            asm volatile("s_waitcnt vmcnt(0)" ::: "memory");
        } else {
            XB_SPIN(xb_ld(&bar[XB_XGEN(bx)]) == gen, bar);
            __builtin_amdgcn_fence(__ATOMIC_ACQUIRE, "agent");
            asm volatile("s_waitcnt vmcnt(0)" ::: "memory");
        }
    }
    __syncthreads();
}

struct Args { const float* in[21]; float* out; unsigned char* ws; };
struct Frame {
    LAS unsigned char* lds;
    volatile LAS unsigned* MISC;
    gu32* ctl;
    int tid, lane, wave, G;
    unsigned char* ws;
    float* out;
};
__device__ __forceinline__ int lane_id_now() { unsigned z = 0u; asm volatile("" : "+v"(z)); return (int)__builtin_amdgcn_mbcnt_hi(~0u, __builtin_amdgcn_mbcnt_lo(~0u, z)); }
__device__ __forceinline__ float bf2f(unsigned b) { return __builtin_bit_cast(float, b << 16); }
__device__ __forceinline__ float bflo(unsigned w) { return __builtin_bit_cast(float, w << 16); }
__device__ __forceinline__ float bfhi(unsigned w) { return __builtin_bit_cast(float, w & 0xffff0000u); }
__device__ __forceinline__ float wave_sum(float v) {
#pragma unroll
    for (int o = 1; o < 64; o <<= 1) v += __shfl_xor(v, o);
    return v;
}
template <class RowMap>
__device__ __forceinline__ void tr_item(const float* W, int K, int N, const float* gain, bf16* WT, RowMap rm, LAS float* scr, int item, int lane) {
    const int nblk = (N + 31) / 32, kb = item / nblk, nb = item % nblk, k0 = 64 * kb, n0 = 32 * nb;
    const int nn = n0 + (lane & 31);
    float tv[32];
#pragma unroll
    for (int i = 0; i < 32; ++i) { const int kk = 2 * i + (lane >> 5); tv[i] = (nn < N) ? W[(size_t)(k0 + kk) * N + nn] : 0.f; }
    if (gain) {
#pragma unroll
        for (int i = 0; i < 32; ++i) tv[i] *= gain[k0 + 2 * i + (lane >> 5)]; }
#pragma unroll
    for (int i = 0; i < 32; ++i) scr[(2 * i + (lane >> 5)) * 33 + (lane & 31)] = tv[i];
    LDS_WAIT(); asm volatile("" ::: "memory");
    const int c = lane & 7;
#pragma unroll
    for (int j = 0; j < 4; ++j) { const int n = (lane >> 3) + 8 * j; const LAS float* s = scr + (8 * c) * 33 + n;
        v4u o; o.x = pk2(s[0 * 33], s[1 * 33]); o.y = pk2(s[2 * 33], s[3 * 33]); o.z = pk2(s[4 * 33], s[5 * 33]); o.w = pk2(s[6 * 33], s[7 * 33]);
        if (n0 + n < N) *(GAS v4u*)(WT + (size_t)rm(n0 + n) * K + k0 + 8 * c) = o; }
    LDS_WAIT(); asm volatile("" ::: "memory");
}
__device__ __forceinline__ void tr_item_pool(const float* Wout, const float* wpool  , const float* pscale  , bf16* WT, LAS float* scr, int g, int nb, int lane) {
    const int k0 = 512 + 64 * g, n0 = 32 * nb;
#pragma unroll 8
    for (int i = 0; i < 32; ++i) { const int kk = 2 * i + (lane >> 5); scr[kk * 33 + (lane & 31)] = Wout[(size_t)(k0 + kk) * 1024 + n0 + (lane & 31)] * pscale[64 * g + kk]; }
    LDS_WAIT(); asm volatile("" ::: "memory");
    float o[32];
    const int nl = lane & 31;
#pragma unroll
    for (int i = 0; i < 32; ++i) { const float* wr_ = wpool + (size_t)(g * 64 + 2 * i + (lane >> 5)) * 64; float a = 0.f;
        for (int d4 = 0; d4 < 16; ++d4) { const f32x4 w = *(const f32x4*)(wr_ + 4 * d4);
            a += (w[0] * scr[(4 * d4) * 33 + nl] + w[1] * scr[(4 * d4 + 1) * 33 + nl]) + (w[2] * scr[(4 * d4 + 2) * 33 + nl] + w[3] * scr[(4 * d4 + 3) * 33 + nl]); }
        o[i] = a; }
    LDS_WAIT(); asm volatile("" ::: "memory");
#pragma unroll
    for (int i = 0; i < 32; ++i) scr[(2 * i + (lane >> 5)) * 33 + (lane & 31)] = o[i];
    LDS_WAIT(); asm volatile("" ::: "memory");
    const int c = lane & 7;
#pragma unroll
    for (int j = 0; j < 4; ++j) { const int n = (lane >> 3) + 8 * j; const LAS float* s = scr + (8 * c) * 33 + n;
        v4u o2; o2.x = pk2(s[0 * 33], s[1 * 33]); o2.y = pk2(s[2 * 33], s[3 * 33]); o2.z = pk2(s[4 * 33], s[5 * 33]); o2.w = pk2(s[6 * 33], s[7 * 33]);
        *(GAS v4u*)(WT + (size_t)(n0 + n) * 1024 + k0 + 8 * c) = o2; }
    LDS_WAIT(); asm volatile("" ::: "memory");
}
template <class RowMap>
__device__ __forceinline__ void cmax_item(const float* W, int K, int N, const float* gain, unsigned* cmx, RowMap rm, int item, int lane) {
    const int nblk = (N + 31) / 32, kb = item / nblk, nb = item % nblk, k0 = 64 * kb, n0 = 32 * nb; const int nn = n0 + (lane & 31);
    float tv[32];
#pragma unroll
    for (int i = 0; i < 32; ++i) { const int kk = 2 * i + (lane >> 5); tv[i] = (nn < N) ? W[(size_t)(k0 + kk) * N + nn] : 0.f; }
    float mx = 0.f;
#pragma unroll
    for (int i = 0; i < 32; ++i) mx = fmaxf(mx, fabsf(gain ? tv[i] * gain[k0 + 2 * i + (lane >> 5)] : tv[i]));
    mx = fmaxf(mx, __shfl_xor(mx, 32));
    if (lane < 32 && nn < N) atomicMax(cmx + rm(nn), __builtin_bit_cast(unsigned, mx));
}
template <class RowMap>
__device__ __forceinline__ void q8_item(const float* W, int K, int N, const float* gain, signed char* W8, const unsigned* cmx, float* sw, RowMap rm, LAS float* scr, int item, int lane) {
    const int nblk = (N + 31) / 32, kb = item / nblk, nb = item % nblk, k0 = 64 * kb, n0 = 32 * nb; const int nn = n0 + (lane & 31);
    float tv[32];
#pragma unroll
    for (int i = 0; i < 32; ++i) { const int kk = 2 * i + (lane >> 5); tv[i] = (nn < N) ? W[(size_t)(k0 + kk) * N + nn] : 0.f; }
    const float cm = (nn < N) ? __builtin_bit_cast(float, cmx[rm(nn)]) : 0.f;
    const float inv = cm > 0.f ? 127.0f / cm : 0.f;
    if (kb == 0 && lane < 32 && nn < N) sw[rm(nn)] = cm * (1.0f / 127.0f);
#pragma unroll
    for (int i = 0; i < 32; ++i) scr[(2 * i + (lane >> 5)) * 33 + (lane & 31)] = __builtin_rintf(tv[i] * gain[k0 + 2 * i + (lane >> 5)] * inv);
    LDS_WAIT(); asm volatile("" ::: "memory");
    const int n = lane >> 1, hf = lane & 1; const LAS float* s = scr + (32 * hf) * 33 + n;
    unsigned pk[8];
#pragma unroll
    for (int j = 0; j < 8; ++j) { const int a = (int)s[(4 * j) * 33], b = (int)s[(4 * j + 1) * 33], c = (int)s[(4 * j + 2) * 33], d = (int)s[(4 * j + 3) * 33];
        pk[j] = (unsigned)(a & 255) | ((unsigned)(b & 255) << 8) | ((unsigned)(c & 255) << 16) | ((unsigned)(d & 255) << 24); }
    if (n0 + n < N) { GAS v4u* dst = (GAS v4u*)(W8 + (size_t)rm(n0 + n) * K + k0 + 32 * hf); dst[0] = (v4u){pk[0], pk[1], pk[2], pk[3]}; dst[1] = (v4u){pk[4], pk[5], pk[6], pk[7]}; }
    LDS_WAIT(); asm volatile("" ::: "memory");
}
template <class RowMap>
__device__ __forceinline__ void f8_item(const float* W, int K, int N, unsigned char* W8, const unsigned* cmx, float* sw, RowMap rm, LAS float* scr, int item, int lane) {
    const int nblk = (N + 31) / 32, kb = item / nblk, nb = item % nblk, k0 = 64 * kb, n0 = 32 * nb; const int nn = n0 + (lane & 31);
    float tv[32];
#pragma unroll
    for (int i = 0; i < 32; ++i) { const int kk = 2 * i + (lane >> 5); tv[i] = (nn < N) ? W[(size_t)(k0 + kk) * N + nn] : 0.f; }
    const float cm = (nn < N) ? __builtin_bit_cast(float, cmx[rm(nn)]) : 0.f;
    const float inv = cm > 0.f ? 256.0f / cm : 0.f;
    if (kb == 0 && lane < 32 && nn < N) sw[rm(nn)] = cm * (1.0f / 256.0f);
#pragma unroll
    for (int i = 0; i < 32; ++i) scr[(2 * i + (lane >> 5)) * 33 + (lane & 31)] = tv[i] * inv;
    LDS_WAIT(); asm volatile("" ::: "memory");
    const int n = lane >> 1, hf = lane & 1; const LAS float* s = scr + (32 * hf) * 33 + n;
    unsigned pk[8];
#pragma unroll
    for (int j = 0; j < 8; ++j) { int p = __builtin_amdgcn_cvt_pk_fp8_f32(s[(4 * j) * 33], s[(4 * j + 1) * 33], 0, false); p = __builtin_amdgcn_cvt_pk_fp8_f32(s[(4 * j + 2) * 33], s[(4 * j + 3) * 33], p, true); pk[j] = (unsigned)p; }
    if (n0 + n < N) { GAS v4u* dst = (GAS v4u*)(W8 + (size_t)rm(n0 + n) * K + k0 + 32 * hf); dst[0] = (v4u){pk[0], pk[1], pk[2], pk[3]}; dst[1] = (v4u){pk[4], pk[5], pk[6], pk[7]}; }
    LDS_WAIT(); asm volatile("" ::: "memory");
}
__device__ __forceinline__ void xquant_phase(Frame& F, int ver, int skipwg = 0) {
    int tid_ = F.wave * 64 + lane_id_now(); unsigned char* ws_ = F.ws; asm volatile("" : "+s"(ws_));
    if ((int)blockIdx.x < skipwg) return;
    const int lane = tid_ & 63, gw = ((int)blockIdx.x - skipwg) * NWAVES + (tid_ >> 6), NGW = (F.G - skipwg) * NWAVES;
    const GAS bf16* XB = (const GAS bf16*)(ws_ + WS_XB); GAS signed char* XQ = (GAS signed char*)(ws_ + WS_XQ); GAS float* SX = (GAS float*)(ws_ + WS_SX); const GAS pg8::u64_t* SS = (const GAS pg8::u64_t*)(ws_ + WS_SSP) + (size_t)ver * T;
    for (int row = gw; row < T; row += NGW) {
        const GAS v4u* src = (const GAS v4u*)(XB + (size_t)row * DM + 16 * lane); const v4u a = src[0], b = src[1];
        const unsigned wd[8] = {a.x, a.y, a.z, a.w, b.x, b.y, b.z, b.w};
        float f[16]; float mx = 0.f;
#pragma unroll
        for (int j = 0; j < 8; ++j) { f[2 * j] = bflo(wd[j]); f[2 * j + 1] = bfhi(wd[j]); mx = fmaxf(mx, fmaxf(fabsf(f[2 * j]), fabsf(f[2 * j + 1]))); }
#pragma unroll
        for (int o = 1; o < 64; o <<= 1) mx = fmaxf(mx, __shfl_xor(mx, o));
        const float inv = mx > 0.f ? 127.0f / mx : 0.f;
        unsigned pk[4];
#pragma unroll
        for (int j = 0; j < 4; ++j) { const int q0 = (int)__builtin_rintf(f[4 * j] * inv), q1 = (int)__builtin_rintf(f[4 * j + 1] * inv), q2 = (int)__builtin_rintf(f[4 * j + 2] * inv), q3 = (int)__builtin_rintf(f[4 * j + 3] * inv);
            pk[j] = (unsigned)(q0 & 255) | ((unsigned)(q1 & 255) << 8) | ((unsigned)(q2 & 255) << 16) | ((unsigned)(q3 & 255) << 24); }
        *(GAS v4u*)(XQ + (size_t)row * DM + 16 * lane) = (v4u){pk[0], pk[1], pk[2], pk[3]};
        if (lane == 0) SX[row] = mx * (1.0f / 127.0f) * __builtin_amdgcn_rsqf(pg8::ss_val(SS[row]) * (1.0f / 1024.0f) + 1e-6f);
    }
}
struct RmNat { int off; __device__ __forceinline__ int operator()(int n) const { return n + off; } };
struct RmGate { int off; __device__ __forceinline__ int operator()(int n) const { return (n >> 7) * 256 + off + (n & 127); } };
__device__ __forceinline__ int headperm(int c) { const int h = c >> 6, d = c & 63; return 256 * (h >> 2) + 128 * (d >> 5) + 32 * (h & 3) + (d & 31); }
struct RmIn { __device__ __forceinline__ int operator()(int n) const {
    if (n < 1536) return (n / 512) * 512 + headperm(n % 512);
    if (n < 1792) return n;
    if (n < 1856) return 2304 + (n - 1792);
    if (n < 1860) return 2304 + 64 + (n - 1856);
    if (n < 2116) return 1792 + (n - 1860);
    return 2048 + headperm(n - 2116); } };
struct RmKV { int layer; __device__ __forceinline__ int operator()(int n) const { return layer * 512 + (n >> 8) * 256 + headperm(n & 255); } };
__device__ __forceinline__ void p0_prologue(Frame& F, const Args& args) {
    LAS float* scr = (LAS float*)(F.lds + RING_OFF + F.wave * 16384);
    const int gw = blockIdx.x * NWAVES + F.wave, NGW = F.G * NWAVES, lane = F.lane;
    constexpr int I_GU = (DM / 64) * (DFF / 32), I_D = (DFF / 64) * (DM / 32), I_IN = (DM / 64) * ((DIN + 31) / 32), I_OUT = (DM / 64) * (DM / 32), I_KV = (DM / 64) * (512 / 32);
    constexpr int PER_LAYER = 4 * I_GU + 2 * I_D + I_IN + I_OUT + I_KV;
    for (int it = gw; it < DEPTH * PER_LAYER; it += NGW) {
        const int l = it / PER_LAYER; int r = it % PER_LAYER;
        unsigned char* wl = F.ws + WS_W + (size_t)l * WL_STRIDE;
        unsigned* cmx = (unsigned*)(F.ws + WS_CMX) + (size_t)l * 2 * NGU;
        if (r < I_GU) { cmax_item(args.in[3] + (size_t)l * DM * DFF, DM, DFF, args.in[2] + l * DM, cmx, RmGate{0}, r, lane); continue; } r -= I_GU;
        if (r < I_GU) { cmax_item(args.in[4] + (size_t)l * DM * DFF, DM, DFF, args.in[2] + l * DM, cmx, RmGate{128}, r, lane); continue; } r -= I_GU;
        if (r < I_D)  { cmax_item(args.in[5] + (size_t)l * DFF * DM, DFF, DM, nullptr, (unsigned*)(F.ws + WS_CMXD) + (size_t)(2 * l) * DM, RmNat{0}, r, lane); continue; } r -= I_D;
        if (r < I_GU) { cmax_item(args.in[18] + (size_t)l * DM * DFF, DM, DFF, args.in[17] + l * DM, cmx + NGU, RmGate{0}, r, lane); continue; } r -= I_GU;
        if (r < I_GU) { cmax_item(args.in[19] + (size_t)l * DM * DFF, DM, DFF, args.in[17] + l * DM, cmx + NGU, RmGate{128}, r, lane); continue; } r -= I_GU;
        if (r < I_D)  { cmax_item(args.in[20] + (size_t)l * DFF * DM, DFF, DM, nullptr, (unsigned*)(F.ws + WS_CMXD) + (size_t)(2 * l + 1) * DM, RmNat{0}, r, lane); continue; } r -= I_D;
        if (r < I_IN) { tr_item(args.in[8] + (size_t)l * DM * DIN, DM, DIN, args.in[6] + l * DM, (bf16*)(wl + WL_IN), RmIn{}, scr, r, lane); continue; } r -= I_IN;
        if (r < I_OUT) { const int kb = r / 32, nb = r % 32;
            if (kb >= 8 && kb < 12) tr_item_pool(args.in[16] + (size_t)l * DM * DM, args.in[11] + (size_t)l * 4 * 64 * 64, args.in[12] + l * 256, (bf16*)(wl + WL_OUT), scr, kb - 8, nb, lane);
            else tr_item(args.in[16] + (size_t)l * DM * DM, DM, DM, nullptr, (bf16*)(wl + WL_OUT), RmNat{0}, scr, r, lane);
            continue; } r -= I_OUT;
        tr_item(args.in[13] + (size_t)l * DM * 512, DM, 512, args.in[7] + l * DM, (bf16*)(F.ws + WS_WKV), RmKV{l}, scr, r, lane);
    }
    if (blockIdx.x == 0) { float* gn = (float*)(F.ws + WS_GN); for (int i = F.tid; i < 4 * DEPTH * 64; i += NWAVES * 64) { const int ty = i / (DEPTH * 64), r = i % (DEPTH * 64); gn[i] = (ty == 0 ? args.in[9] : ty == 1 ? args.in[10] : ty == 2 ? args.in[14] : args.in[15])[r]; } }
    for (int it = gw; it < DEPTH * 188; it += NGW) { const int l = it / 188, rr = 2304 + 68 + it % 188;
        GAS v4u* p = (GAS v4u*)((bf16*)(F.ws + WS_W + (size_t)l * WL_STRIDE + WL_IN) + (size_t)rr * DM); p[lane] = (v4u){0u, 0u, 0u, 0u}; p[lane + 64] = (v4u){0u, 0u, 0u, 0u}; }
    for (int m = gw; m < T + 512; m += NGW) {
        const bool ismem = m >= T; const int row = ismem ? m - T : m;
        const GAS f32x4* xr = (const GAS f32x4*)((ismem ? args.in[1] : args.in[0]) + (size_t)row * DM) + lane;
        f32x4 v[4]; float s = 0.f;
#pragma unroll
        for (int j = 0; j < 4; ++j) { v[j] = xr[64 * j]; s += (v[j][0] * v[j][0] + v[j][1] * v[j][1]) + (v[j][2] * v[j][2] + v[j][3] * v[j][3]); }
        s = wave_sum(s);
        if (lane == 0) { if (ismem) ((float*)(F.ws + WS_SSM))[row] = s; else ((pg8::u64_t*)(F.ws + WS_SSP))[row] = (pg8::u64_t)(s * pg8::SS_FIX); }
        GAS unsigned long long* o8 = (GAS unsigned long long*)((bf16*)(F.ws + (ismem ? WS_MEMB : WS_XB)) + (size_t)row * DM) + lane;
        unsigned pw[4][2];
#pragma unroll
        for (int j = 0; j < 4; ++j) { pw[j][0] = pk2(v[j][0], v[j][1]); pw[j][1] = pk2(v[j][2], v[j][3]); o8[64 * j] = (unsigned long long)pw[j][0] | ((unsigned long long)pw[j][1] << 32); }
        if (!ismem) {
            float mx = 0.f;
#pragma unroll
            for (int j = 0; j < 4; ++j) mx = fmaxf(mx, fmaxf(fmaxf(fabsf(bflo(pw[j][0])), fabsf(bfhi(pw[j][0]))), fmaxf(fabsf(bflo(pw[j][1])), fabsf(bfhi(pw[j][1])))));
#pragma unroll
            for (int o = 1; o < 64; o <<= 1) mx = fmaxf(mx, __shfl_xor(mx, o));
            const float inv = mx > 0.f ? 127.0f / mx : 0.f;
            GAS unsigned* q4 = (GAS unsigned*)((GAS signed char*)(F.ws + WS_XQ) + (size_t)row * DM) + lane;
#pragma unroll
            for (int j = 0; j < 4; ++j) { const int q0 = (int)__builtin_rintf(bflo(pw[j][0]) * inv), q1 = (int)__builtin_rintf(bfhi(pw[j][0]) * inv), q2 = (int)__builtin_rintf(bflo(pw[j][1]) * inv), q3 = (int)__builtin_rintf(bfhi(pw[j][1]) * inv);
                q4[64 * j] = (unsigned)(q0 & 255) | ((unsigned)(q1 & 255) << 8) | ((unsigned)(q2 & 255) << 16) | ((unsigned)(q3 & 255) << 24); }
            if (lane == 0) ((float*)(F.ws + WS_SX))[row] = mx * (1.0f / 127.0f) * __builtin_amdgcn_rsqf(s * (1.0f / 1024.0f) + 1e-6f);
        }
    }
}

__device__ __forceinline__ void p0b_quant(Frame& F, const Args& args, int skipwg) {
    LAS float* scr = (LAS float*)(F.lds + RING_OFF + F.wave * 16384);
    if ((int)blockIdx.x < skipwg) return;
    const int lane = lane_id_now(), gw = ((int)blockIdx.x - skipwg) * NWAVES + F.wave, NGW = (F.G - skipwg) * NWAVES;
    constexpr int I_GU = (DM / 64) * (DFF / 32);
    for (int it = gw; it < DEPTH * 4 * I_GU; it += NGW) {
        const int l = it / (4 * I_GU); int r = it % (4 * I_GU); const int f = r / (2 * I_GU); r %= 2 * I_GU; const int up = r / I_GU; r %= I_GU;
        const float* W = (f == 0 ? (up ? args.in[4] : args.in[3]) : (up ? args.in[19] : args.in[18])) + (size_t)l * DM * DFF; const float* gn = (f == 0 ? args.in[2] : args.in[17]) + l * DM;
        signed char* W8 = (signed char*)(F.ws + WS_W + (size_t)l * WL_STRIDE + (f == 0 ? WL_1GU : WL_2GU));
        const unsigned* cmx = (const unsigned*)(F.ws + WS_CMX) + ((size_t)l * 2 + f) * NGU; float* sw = (float*)(F.ws + WS_SW) + ((size_t)l * 2 + f) * NGU;
        q8_item(W, DM, DFF, gn, W8, cmx, sw, RmGate{up ? 128 : 0}, scr, r, lane);
    }
    constexpr int I_D = (DFF / 64) * (DM / 32);
    for (int it = gw; it < DEPTH * 2 * I_D; it += NGW) {
        const int l = it / (2 * I_D); int r = it % (2 * I_D); const int f = r / I_D; r %= I_D;
        f8_item((f == 0 ? args.in[5] : args.in[20]) + (size_t)l * DFF * DM, DFF, DM, F.ws + WS_W + (size_t)l * WL_STRIDE + (f == 0 ? WL_1D : WL_2D),
                (const unsigned*)(F.ws + WS_CMXD) + (size_t)(2 * l + f) * DM, (float*)(F.ws + WS_SWD) + (size_t)(2 * l + f) * DM, RmNat{0}, scr, r, lane);
    }
}
__device__ __forceinline__ void pool_phase(Frame& F) {
    int tid_ = F.wave * 64 + lane_id_now(); unsigned char* ws_ = F.ws; asm volatile("" : "+s"(ws_));
    const bf16* PU = (const bf16*)(ws_ + WS_PU); bf16* CAT = (bf16*)(ws_ + WS_CAT);
    for (int it0 = blockIdx.x * 512 + tid_; it0 < T * 32; it0 += 2 * F.G * 512) {
        v4u vv[2][16]; int nn[2], qq[2], cc[2];
#pragma unroll
        for (int s = 0; s < 2; ++s) { const int it = it0 + s * F.G * 512; const bool ok = it < T * 32;
            const int q = it >> 5, ch = it & 31, t = q & (SEQ - 1), g = ch >> 3, win = 2 << g, n = ok ? ((t + 1 < win) ? t + 1 : win) : 0;
            nn[s] = n; qq[s] = q; cc[s] = ch;
#pragma unroll
            for (int j = 0; j < 16; ++j) { vv[s][j] = (v4u){0u, 0u, 0u, 0u}; if (j < n) vv[s][j] = *(const v4u*)(PU + (size_t)(q - j) * 256 + 8 * ch); } }
#pragma unroll
        for (int s = 0; s < 2; ++s) { if (nn[s] == 0) continue;
            float a[8] = {0.f, 0.f, 0.f, 0.f, 0.f, 0.f, 0.f, 0.f}, u0[8] = {0.f, 0.f, 0.f, 0.f, 0.f, 0.f, 0.f, 0.f};
#pragma unroll
            for (int j = 0; j < 16; ++j) { const v4u v = vv[s][j];
                const float f[8] = {bflo(v.x), bfhi(v.x), bflo(v.y), bfhi(v.y), bflo(v.z), bfhi(v.z), bflo(v.w), bfhi(v.w)};
#pragma unroll
                for (int e = 0; e < 8; ++e) { a[e] += f[e]; if (j == 0) u0[e] = f[e]; } }
            const float inv = 1.0f / (float)nn[s];
            v4u o; o.x = pk2(a[0] * inv - u0[0], a[1] * inv - u0[1]); o.y = pk2(a[2] * inv - u0[2], a[3] * inv - u0[3]); o.z = pk2(a[4] * inv - u0[4], a[5] * inv - u0[5]); o.w = pk2(a[6] * inv - u0[6], a[7] * inv - u0[7]);
            *(v4u*)(CAT + (size_t)qq[s] * 1024 + 512 + 8 * cc[s]) = o; }
    }
}
namespace att {
typedef float f32x16 __attribute__((ext_vector_type(16)));
typedef short s16x4 __attribute__((ext_vector_type(4)));
typedef short v4i16_t __attribute__((ext_vector_type(4)));
constexpr int SLOTB = 8192;
constexpr int L_K = 0, L_V = 4 * SLOTB, L_M = 8 * SLOTB, L_SC = L_M + 8 * 2048, L_OST = L_SC + 1024, L_END = L_OST + 8 * 4096;
static_assert(L_END <= 131072, "attention LDS");
__device__ __forceinline__ void glds16(const void* gsrc, unsigned lds_dst) { unsigned keep;
    asm volatile("s_mov_b32 %0, m0\n\ts_mov_b32 m0, %2\n\ts_nop 0\n\tglobal_load_lds_dwordx4 %1, off\n\ts_mov_b32 m0, %0" : "=&s"(keep) : "v"(gsrc), "s"(lds_dst) : "memory"); }
__device__ __forceinline__ void glds16s(const void* sbase, unsigned voff, unsigned lds_dst) { unsigned keep;
    asm volatile("s_mov_b32 %0, m0\n\ts_mov_b32 m0, %3\n\ts_nop 0\n\tglobal_load_lds_dwordx4 %1, %2\n\ts_mov_b32 m0, %0" : "=&s"(keep) : "v"(voff), "s"(sbase), "s"(lds_dst) : "memory"); }
__device__ __forceinline__ s16x4 vtr(LAS const unsigned char* p) { return __builtin_bit_cast(s16x4, __builtin_amdgcn_ds_read_tr16_b64_v4i16((LAS v4i16_t*)p)); }
__device__ __forceinline__ unsigned cvtpk(float lo, float hi) { typedef float f2 __attribute__((ext_vector_type(2))); typedef __bf16 b2 __attribute__((ext_vector_type(2))); f2 v = {lo, hi}; b2 b = __builtin_convertvector(v, b2); return __builtin_bit_cast(unsigned, b); }
__device__ __forceinline__ int crow(int r, int hi) { return (r & 3) + 8 * (r >> 2) + 4 * hi; }
__device__ __forceinline__ float maskexp(float x, unsigned w, int pos) {
    const unsigned m = (unsigned)__builtin_amdgcn_sbfe((int)w, pos, 1);
    const unsigned xb = (__builtin_bit_cast(unsigned, x) & m) | (0xff800000u & ~m);
    return __builtin_amdgcn_exp2f(__builtin_bit_cast(float, xb));
}

template <bool MEM>
__device__ __forceinline__ void unit(int h, int qb, const bf16* Qg, const bf16* Kg, const bf16* Vg, const unsigned* BMb, bf16* CATb, LAS unsigned char* lds, int tid, float moff) {
    constexpr int PQ = MEM ? 256 : 512;
    const int lane = tid & 63, r32 = lane & 31, hi = lane >> 5; const int wid = __builtin_amdgcn_readfirstlane(tid >> 6);
    const int q0 = qb * 256, qrow = q0 + wid * 32 + r32;
    const bf16* Qw = Qg + (size_t)qrow * PQ + h * 64;
    const unsigned lds0 = (unsigned)(uintptr_t)lds;
    const int krow = MEM ? lane : ((((lane >> 2) & 1) << 5) | ((lane >> 5) << 4) | (((lane >> 3) & 3) << 2) | (lane & 3));
    const unsigned ksrc = MEM ? (unsigned)(h * 64 + krow * PQ + wid * 8) * 2u : (unsigned)(h * 64 + krow * 512 + (wid & 3) * 16);
    const bool kq = MEM || wid < 4;
    const unsigned vsrc = MEM ? (unsigned)(h * 64 + (16 * (wid & 3) + (lane >> 2)) * PQ + (wid >> 2) * 32 + (lane & 3) * 8) * 2u
                              : (unsigned)((h * 64 + lane) * SEQ + (wid & 3) * 16);
    const bool vq = MEM || wid >= 4;
    const unsigned kdst = lds0 + L_K + wid * 1024, vdst8 = lds0 + L_V + (MEM ? wid : (wid & 3)) * 1024, mdst = lds0 + L_M + wid * 2048;
    const unsigned msrc = (unsigned)((q0 + wid * 32 + (lane >> 1)) * 512 + (lane & 1) * 4) * 4u;
    const int NT = MEM ? 4 : (q0 + 256) / 64;
#define ATT_DMA_K(t) if (kq) glds16s(Kg, ksrc + (unsigned)(t) * (MEM ? 64 * PQ * 2 : 64 * 512), (unsigned)__builtin_amdgcn_readfirstlane(kdst + (unsigned)((t) & 3) * SLOTB))
#define ATT_DMA_V(t) if (vq) glds16s(Vg, vsrc + (unsigned)(t) * (MEM ? 64 * PQ * 2 : 64), (unsigned)__builtin_amdgcn_readfirstlane(vdst8 + (unsigned)((t) & 3) * SLOTB))
#define ATT_DMA_KS(t, slot) if (kq) glds16s(Kg, ksrc + (unsigned)(t) * (MEM ? 64 * PQ * 2 : 64 * 512), (unsigned)__builtin_amdgcn_readfirstlane(kdst + (unsigned)(slot) * SLOTB))
#define ATT_DMA_VS(t, slot) if (vq) glds16s(Vg, vsrc + (unsigned)(t) * (MEM ? 64 * PQ * 2 : 64), (unsigned)__builtin_amdgcn_readfirstlane(vdst8 + (unsigned)(slot) * SLOTB))
#define ATT_DMA_M(g) glds16s(BMb, msrc + (unsigned)(g) * 32, (unsigned)__builtin_amdgcn_readfirstlane(mdst + (unsigned)((g) & 1) * 1024))
#define ATT_QK(P0, P1, t) do { LAS const unsigned char* Ks_ = (LAS const unsigned char*)(uintptr_t)(((unsigned)(uintptr_t)(lds + L_K + ((t) & 3) * SLOTB + hi * 1024 + r32 * 16)) & 0x3ffffu); P0 = cinit; P1 = cinit; \
        _Pragma("unroll") for (int d0 = 0; d0 < 4; ++d0) { const bf16x8 b0 = *(LAS const bf16x8*)(Ks_ + d0 * 2048), b1 = *(LAS const bf16x8*)(Ks_ + d0 * 2048 + 512); \
            P0 = __builtin_amdgcn_mfma_f32_32x32x16_bf16(b0, qr[d0], P0, 0, 0, 0); P1 = __builtin_amdgcn_mfma_f32_32x32x16_bf16(b1, qr[d0], P1, 0, 0, 0); } } while (0)
    bf16x8 qr[4];
    typedef int v4i_ __attribute__((ext_vector_type(4))); typedef int v8i_ __attribute__((ext_vector_type(8)));
    v8i_ q8 = {0, 0, 0, 0, 0, 0, 0, 0};
    if (MEM) {
#pragma unroll
        for (int d0 = 0; d0 < 4; ++d0) qr[d0] = *(const bf16x8*)(Qw + d0 * 16 + hi * 8); }
    else { const unsigned char* Q8 = (const unsigned char*)Qg + (size_t)qrow * 512 + h * 64 + 32 * hi;
        const v4i_ lo = *(const v4i_*)Q8, hi4 = *(const v4i_*)(Q8 + 16); q8 = __builtin_shufflevector(lo, hi4, 0, 1, 2, 3, 4, 5, 6, 7); }
    v8i_ ones8 = {0x38383838, 0x38383838, 0x38383838, 0x38383838, 0x38383838, 0x38383838, 0x38383838, 0x38383838};
    v8i_ pw8 = {0, 0, 0, 0, 0, 0, 0, 0}, pwb = {0, 0, 0, 0, 0, 0, 0, 0};
#define ATT_PV8P(P_, O, lo_, hi_) O = __builtin_amdgcn_mfma_scale_f32_32x32x64_f8f6f4(P_, __builtin_shufflevector(__builtin_bit_cast(v4i_, lo_), __builtin_bit_cast(v4i_, hi_), 0, 1, 2, 3, 4, 5, 6, 7), O, 0, 0, 0, 0, 0, 0)
#define ATT_PV8(O, lo_, hi_) O = __builtin_amdgcn_mfma_scale_f32_32x32x64_f8f6f4(pw8, __builtin_shufflevector(__builtin_bit_cast(v4i_, lo_), __builtin_bit_cast(v4i_, hi_), 0, 1, 2, 3, 4, 5, 6, 7), O, 0, 0, 0, 0, 0, 0)
#define ATT_QK8(P, lo_, hi_) P = __builtin_amdgcn_mfma_scale_f32_32x32x64_f8f6f4(__builtin_shufflevector(__builtin_bit_cast(v4i_, lo_), __builtin_bit_cast(v4i_, hi_), 0, 1, 2, 3, 4, 5, 6, 7), q8, cinit, 0, 0, 0, 0, 0, 0)
    f32x16 o0, o1, o2; const f32x16 cinit = {0.f, 0.f, 0.f, 0.f, 0.f, 0.f, 0.f, 0.f, 0.f, 0.f, 0.f, 0.f, 0.f, 0.f, 0.f, 0.f};
#pragma unroll
    for (int r = 0; r < 16; ++r) { o0[r] = 0.f; o1[r] = 0.f; o2[r] = 0.f; }
    (void)moff;
    asm volatile("" ::: "memory");
    if (!MEM) { ATT_DMA_M(0); *(LAS v4u*)(lds + L_V + 3 * SLOTB + wid * 1024 + lane * 16) = (v4u){0u, 0u, 0u, 0u};
        { const unsigned nb = (unsigned)(tid >> 1) >> ((tid & 1) * 4);
          ((LAS unsigned*)(lds + L_K + 4096))[tid] = ((nb & 1) ? 0xffu : 0u) | ((nb & 2) ? 0xff00u : 0u) | ((nb & 4) ? 0xff0000u : 0u) | ((nb & 8) ? 0xff000000u : 0u); } }
    ATT_DMA_K(0); ATT_DMA_V(0); ATT_DMA_K(1);
    asm volatile("s_waitcnt vmcnt(0) lgkmcnt(0)\n\ts_barrier" ::: "memory");
    ATT_DMA_K(2); ATT_DMA_V(1);
    ATT_DMA_K(3); ATT_DMA_V(2);
    f32x16 s0, s1;
    if (MEM) ATT_QK(s0, s1, 0);
    else { LAS const unsigned char* K0 = (LAS const unsigned char*)(uintptr_t)(((unsigned)(uintptr_t)(lds + L_K + hi * 2048 + r32 * 16)) & 0x3ffffu);
        const bf16x8 a0 = *(LAS const bf16x8*)(K0 + 0), a1 = *(LAS const bf16x8*)(K0 + 1024), b0 = *(LAS const bf16x8*)(K0 + 512), b1 = *(LAS const bf16x8*)(K0 + 1536);
        ATT_QK8(s0, a0, a1); ATT_QK8(s1, b0, b1); }
    typedef float f32x2 __attribute__((ext_vector_type(2)));
    f32x2 la0 = {0.f, 0.f}, la1 = {0.f, 0.f};
    bf16x8 fp[4]; unsigned long long mwp = 0ull; unsigned mkp[8] = {0u, 0u, 0u, 0u, 0u, 0u, 0u, 0u};
    if (!MEM) { __builtin_amdgcn_s_setreg(1 | (23 << 6), 1);
        LAS const unsigned char* V0 = (LAS const unsigned char*)(uintptr_t)(((unsigned)(uintptr_t)(lds + L_V + hi * 2048 + r32 * 16)) & 0x3ffffu);
        fp[0] = *(LAS const bf16x8*)(V0 + 0); fp[1] = *(LAS const bf16x8*)(V0 + 1024); fp[2] = *(LAS const bf16x8*)(V0 + 512); fp[3] = *(LAS const bf16x8*)(V0 + 1536);
        mwp = *(LAS const unsigned long long*)(lds + L_M + wid * 2048 + r32 * 32);
        { const unsigned cw = hi ? (unsigned)(mwp >> 32) : (unsigned)mwp;
#pragma unroll
          for (int j = 0; j < 4; ++j) { typedef unsigned u2_ __attribute__((ext_vector_type(2))); const u2_ m2 = *(LAS const u2_*)(lds + L_K + 4096 + ((j == 0 ? (cw << 3) : (cw >> (8 * j - 3))) & 0x7f8u)); mkp[2 * j] = m2[0]; mkp[2 * j + 1] = m2[1]; } } }
    const bool late = wid >= 4;
    v4u pw[4];
#pragma unroll
    for (int i = 0; i < 4; ++i) pw[i] = (v4u){0u, 0u, 0u, 0u};
    auto pv = [&](const int tv) __attribute__((always_inline)) {
        if (MEM) {
        LAS const unsigned char* Vs = (LAS const unsigned char*)(uintptr_t)(((unsigned)(uintptr_t)(lds + L_V + (tv & 3) * SLOTB + ((lane >> 4) & 1) * 32 + (lane & 3) * 8 + (4 * hi + ((lane & 15) >> 2)) * 64)) & 0x3ffffu);
#pragma unroll
        for (int ks = 0; ks < 4; ++ks) {
            const s16x4 l0 = vtr(Vs + ks * 1024), h0 = vtr(Vs + ks * 1024 + 512), l1 = vtr(Vs + 4096 + ks * 1024), h1 = vtr(Vs + 4096 + ks * 1024 + 512);
            const bf16x8 v0 = (bf16x8){l0[0], l0[1], l0[2], l0[3], h0[0], h0[1], h0[2], h0[3]}, v1 = (bf16x8){l1[0], l1[1], l1[2], l1[3], h1[0], h1[1], h1[2], h1[3]};
            const bf16x8 pa = __builtin_bit_cast(bf16x8, pw[ks]);
            o0 = __builtin_amdgcn_mfma_f32_32x32x16_bf16(pa, v0, o0, 0, 0, 0);
            o1 = __builtin_amdgcn_mfma_f32_32x32x16_bf16(pa, v1, o1, 0, 0, 0);
        }
        } else {
            LAS const unsigned char* Vt = (LAS const unsigned char*)(uintptr_t)(((unsigned)(uintptr_t)(lds + L_V + (tv & 3) * SLOTB + hi * 1024 + r32 * 16)) & 0x3ffffu);
#pragma unroll
            for (int ks = 0; ks < 4; ++ks) {
                const bf16x8 v0 = *(LAS const bf16x8*)(Vt + ks * 2048), v1 = *(LAS const bf16x8*)(Vt + ks * 2048 + 512);
                const bf16x8 pa = __builtin_bit_cast(bf16x8, pw[ks]);
                o0 = __builtin_amdgcn_mfma_f32_32x32x16_bf16(pa, v0, o0, 0, 0, 0);
                o1 = __builtin_amdgcn_mfma_f32_32x32x16_bf16(pa, v1, o1, 0, 0, 0);
            }
        }
    };
    auto step = [&](f32x16& S0, f32x16& S1, f32x16& N0, f32x16& N1, const int t) __attribute__((always_inline)) {
        ATT_QK(N0, N1, t + 1);
        unsigned cw0 = 0xffffffffu, cw1 = 0xffffffffu;
        if (!MEM) { const unsigned long long mw = *(LAS const unsigned long long*)(lds + L_M + wid * 2048 + ((t >> 2) & 1) * 1024 + r32 * 32 + (t & 3) * 8);
            cw0 = (unsigned)mw >> (8 * hi); cw1 = (unsigned)(mw >> 32) >> (8 * hi); }
#pragma unroll
        for (int r = 0; r < 16; ++r) { const int pos = 16 * (r >> 3) + (r & 7);
            if (MEM) { S0[r] = __builtin_amdgcn_exp2f(S0[r]); S1[r] = __builtin_amdgcn_exp2f(S1[r]); }
            else { S0[r] = maskexp(S0[r], cw0, pos); S1[r] = maskexp(S1[r], cw1, pos); } }
#pragma unroll
        for (int r = 0; r < 16; r += 2) { la0 += (f32x2){S0[r], S0[r + 1]}; la1 += (f32x2){S1[r], S1[r + 1]}; }
#pragma unroll
        for (int kk = 0; kk < 2; ++kk) {
            pw[kk][0] = cvtpk(S0[8 * kk + 0], S0[8 * kk + 1]); pw[kk][1] = cvtpk(S0[8 * kk + 2], S0[8 * kk + 3]); pw[kk][2] = cvtpk(S0[8 * kk + 4], S0[8 * kk + 5]); pw[kk][3] = cvtpk(S0[8 * kk + 6], S0[8 * kk + 7]);
            pw[2 + kk][0] = cvtpk(S1[8 * kk + 0], S1[8 * kk + 1]); pw[2 + kk][1] = cvtpk(S1[8 * kk + 2], S1[8 * kk + 3]); pw[2 + kk][2] = cvtpk(S1[8 * kk + 4], S1[8 * kk + 5]); pw[2 + kk][3] = cvtpk(S1[8 * kk + 6], S1[8 * kk + 7]); }
        pv(t);
        const int c = ((t + 3 < NT) ? 1 : 0) + ((t + 2 < NT) ? 1 : 0);
        if (c == 2) asm volatile("s_waitcnt vmcnt(2) lgkmcnt(0)\n\ts_barrier" ::: "memory");
        else if (c == 1) asm volatile("s_waitcnt vmcnt(1) lgkmcnt(0)\n\ts_barrier" ::: "memory");
        else asm volatile("s_waitcnt vmcnt(0) lgkmcnt(0)\n\ts_barrier" ::: "memory");
        if (!MEM && (t & 3) == 0 && 4 * ((t >> 2) + 1) < NT) ATT_DMA_M((t >> 2) + 1);
        if (t + 4 < NT) ATT_DMA_K(t + 4);
        if (t + 3 < NT) ATT_DMA_V(t + 3);
    };
    auto step_late = [&](f32x16& S0, f32x16& S1, f32x16& N0, f32x16& N1, v8i_& PO, v8i_& PN, const int t, const int tm) __attribute__((always_inline)) {
        LAS const unsigned char* Vn = (LAS const unsigned char*)(uintptr_t)(((unsigned)(uintptr_t)(lds + L_V + tm * SLOTB + hi * 2048 + r32 * 16)) & 0x3ffffu);
        LAS const unsigned char* Kt = (LAS const unsigned char*)(uintptr_t)(((unsigned)(uintptr_t)(lds + L_K + ((tm + 1) & 3) * SLOTB + hi * 2048 + r32 * 16)) & 0x3ffffu);
        unsigned mk[8];
#pragma unroll
        for (int j = 0; j < 8; ++j) mk[j] = mkp[j];
        const unsigned long long mwn = *(LAS const unsigned long long*)(lds + L_M + wid * 2048 + (((t + 1) >> 2) & 1) * 1024 + r32 * 32 + ((tm + 1) & 3) * 8);
        bf16x8 f[8];
        f[0] = fp[0]; f[1] = fp[1]; f[2] = fp[2]; f[3] = fp[3];
        f[4] = *(LAS const bf16x8*)(Kt + 0); f[5] = *(LAS const bf16x8*)(Kt + 1024); ATT_PV8P(PO, o0, f[0], f[1]); asm volatile("" : "+v"(o0)); S0[0] = __builtin_amdgcn_exp2f(S0[0]); S0[1] = __builtin_amdgcn_exp2f(S0[1]); S0[2] = __builtin_amdgcn_exp2f(S0[2]); S0[3] = __builtin_amdgcn_exp2f(S0[3]); S0[4] = __builtin_amdgcn_exp2f(S0[4]); S0[5] = __builtin_amdgcn_exp2f(S0[5]); S0[6] = __builtin_amdgcn_exp2f(S0[6]); S0[7] = __builtin_amdgcn_exp2f(S0[7]); __builtin_amdgcn_sched_barrier(0);
        f[6] = *(LAS const bf16x8*)(Kt + 512); f[7] = *(LAS const bf16x8*)(Kt + 1536); ATT_PV8P(PO, o1, f[2], f[3]); asm volatile("" : "+v"(o1)); S0[8] = __builtin_amdgcn_exp2f(S0[8]); S0[9] = __builtin_amdgcn_exp2f(S0[9]); S0[10] = __builtin_amdgcn_exp2f(S0[10]); S0[11] = __builtin_amdgcn_exp2f(S0[11]); S0[12] = __builtin_amdgcn_exp2f(S0[12]); S0[13] = __builtin_amdgcn_exp2f(S0[13]); S0[14] = __builtin_amdgcn_exp2f(S0[14]); S0[15] = __builtin_amdgcn_exp2f(S0[15]); __builtin_amdgcn_sched_barrier(0);
        o2 = __builtin_amdgcn_mfma_scale_f32_32x32x64_f8f6f4(PO, ones8, o2, 0, 0, 0, 0, 0, 0); asm volatile("" : "+v"(o2)); S1[0] = __builtin_amdgcn_exp2f(S1[0]); S1[1] = __builtin_amdgcn_exp2f(S1[1]); S1[2] = __builtin_amdgcn_exp2f(S1[2]); S1[3] = __builtin_amdgcn_exp2f(S1[3]); S1[4] = __builtin_amdgcn_exp2f(S1[4]); S1[5] = __builtin_amdgcn_exp2f(S1[5]); S1[6] = __builtin_amdgcn_exp2f(S1[6]); S1[7] = __builtin_amdgcn_exp2f(S1[7]); __builtin_amdgcn_sched_barrier(0);
        ATT_QK8(N0, f[4], f[5]); asm volatile("" : "+v"(N0)); S1[8] = __builtin_amdgcn_exp2f(S1[8]); S1[9] = __builtin_amdgcn_exp2f(S1[9]); S1[10] = __builtin_amdgcn_exp2f(S1[10]); S1[11] = __builtin_amdgcn_exp2f(S1[11]); S1[12] = __builtin_amdgcn_exp2f(S1[12]); S1[13] = __builtin_amdgcn_exp2f(S1[13]); S1[14] = __builtin_amdgcn_exp2f(S1[14]); S1[15] = __builtin_amdgcn_exp2f(S1[15]); PN[0] = __builtin_amdgcn_cvt_pk_fp8_f32(S0[0], S0[1], PN[0], false); PN[0] = __builtin_amdgcn_cvt_pk_fp8_f32(S0[2], S0[3], PN[0], true); PN[0] &= mk[0]; PN[1] = __builtin_amdgcn_cvt_pk_fp8_f32(S0[4], S0[5], PN[1], false); PN[1] = __builtin_amdgcn_cvt_pk_fp8_f32(S0[6], S0[7], PN[1], true); PN[1] &= mk[1]; asm volatile("" : "+v"(PN)); __builtin_amdgcn_sched_barrier(0);
        ATT_QK8(N1, f[6], f[7]); asm volatile("" : "+v"(N1)); PN[2] = __builtin_amdgcn_cvt_pk_fp8_f32(S0[8], S0[9], PN[2], false); PN[2] = __builtin_amdgcn_cvt_pk_fp8_f32(S0[10], S0[11], PN[2], true); PN[2] &= mk[2]; PN[3] = __builtin_amdgcn_cvt_pk_fp8_f32(S0[12], S0[13], PN[3], false); PN[3] = __builtin_amdgcn_cvt_pk_fp8_f32(S0[14], S0[15], PN[3], true); PN[3] &= mk[3]; PN[4] = __builtin_amdgcn_cvt_pk_fp8_f32(S1[0], S1[1], PN[4], false); PN[4] = __builtin_amdgcn_cvt_pk_fp8_f32(S1[2], S1[3], PN[4], true); PN[4] &= mk[4]; PN[5] = __builtin_amdgcn_cvt_pk_fp8_f32(S1[4], S1[5], PN[5], false); PN[5] = __builtin_amdgcn_cvt_pk_fp8_f32(S1[6], S1[7], PN[5], true); PN[5] &= mk[5]; PN[6] = __builtin_amdgcn_cvt_pk_fp8_f32(S1[8], S1[9], PN[6], false); PN[6] = __builtin_amdgcn_cvt_pk_fp8_f32(S1[10], S1[11], PN[6], true); PN[6] &= mk[6]; PN[7] = __builtin_amdgcn_cvt_pk_fp8_f32(S1[12], S1[13], PN[7], false); PN[7] = __builtin_amdgcn_cvt_pk_fp8_f32(S1[14], S1[15], PN[7], true); PN[7] &= mk[7]; asm volatile("" : "+v"(PN)); __builtin_amdgcn_sched_barrier(0);
        fp[0] = *(LAS const bf16x8*)(Vn + 0); fp[1] = *(LAS const bf16x8*)(Vn + 1024); fp[2] = *(LAS const bf16x8*)(Vn + 512); fp[3] = *(LAS const bf16x8*)(Vn + 1536);
        { const unsigned cw = hi ? (unsigned)(mwn >> 32) : (unsigned)mwn;
#pragma unroll
          for (int j = 0; j < 4; ++j) { typedef unsigned u2_ __attribute__((ext_vector_type(2))); const u2_ m2 = *(LAS const u2_*)(lds + L_K + 4096 + ((j == 0 ? (cw << 3) : (cw >> (8 * j - 3))) & 0x7f8u)); mkp[2 * j] = m2[0]; mkp[2 * j + 1] = m2[1]; } }
        const int c = ((kq && t + 3 < NT) ? 1 : 0) + ((vq && t + 2 < NT) ? 1 : 0);
        if (c == 2) asm volatile("s_waitcnt vmcnt(2) lgkmcnt(0)\n\ts_barrier" ::: "memory");
        else if (c == 1) asm volatile("s_waitcnt vmcnt(1) lgkmcnt(0)\n\ts_barrier" ::: "memory");
        else asm volatile("s_waitcnt vmcnt(0) lgkmcnt(0)\n\ts_barrier" ::: "memory");
        if (tm == 0 && 4 * ((t >> 2) + 1) < NT) ATT_DMA_M((t >> 2) + 1);
        if (t + 4 < NT) ATT_DMA_KS(t + 4, tm);
        if (t + 3 < NT) ATT_DMA_VS(t + 3, (tm + 3) & 3);
    };
    f32x16 n0, n1;
#pragma unroll 1
    for (int t = 0; t < NT; t += 2) {
        if (!MEM) { step_late(s0, s1, n0, n1, pw8, pwb, t, 0); step_late(n0, n1, s0, s1, pwb, pw8, t + 1, 1); step_late(s0, s1, n0, n1, pw8, pwb, t + 2, 2); step_late(n0, n1, s0, s1, pwb, pw8, t + 3, 3); t += 2; }
        else { step(s0, s1, n0, n1, t); step(n0, n1, s0, s1, t + 1); }
    }
    if (!MEM) { LAS const unsigned char* Vl = (LAS const unsigned char*)(uintptr_t)(((unsigned)(uintptr_t)(lds + L_V + ((NT - 1) & 3) * SLOTB + hi * 2048 + r32 * 16)) & 0x3ffffu);
        const bf16x8 v0 = *(LAS const bf16x8*)(Vl + 0), v1 = *(LAS const bf16x8*)(Vl + 1024), v2 = *(LAS const bf16x8*)(Vl + 512), v3 = *(LAS const bf16x8*)(Vl + 1536);
        ATT_PV8(o0, v0, v1); ATT_PV8(o1, v2, v3); o2 = __builtin_amdgcn_mfma_scale_f32_32x32x64_f8f6f4(pw8, ones8, o2, 0, 0, 0, 0, 0, 0); __builtin_amdgcn_s_setreg(1 | (23 << 6), 0); }
    float lsum = (la0[0] + la0[1]) + (la1[0] + la1[1]);
    lsum += __shfl_xor(lsum, 32);
    LAS float* sc = (LAS float*)(lds + L_SC) + wid * 32;
    LAS unsigned short* ost = (LAS unsigned short*)(lds + L_OST + wid * 4096);
    if (hi == 0) sc[r32] = lsum;
    asm volatile("s_waitcnt lgkmcnt(0)" ::: "memory");
#pragma unroll
    for (int r = 0; r < 16; ++r) { const int qq = crow(r, hi); const float inv = 1.0f / (MEM ? sc[qq] : fmaxf(o2[r], 1.0e-30f));
        ost[qq * 64 + r32] = (unsigned short)f2bf(o0[r] * inv); ost[qq * 64 + 32 + r32] = (unsigned short)f2bf(o1[r] * inv); }
    asm volatile("s_waitcnt lgkmcnt(0)" ::: "memory");
#pragma unroll
    for (int i = 0; i < 4; ++i) { const int row = (lane >> 3) + 8 * i, ch = lane & 7;
        const v4u v = *(LAS const v4u*)((LAS const unsigned char*)ost + row * 128 + ch * 16);
        *(v4u*)(CATb + (size_t)(q0 + wid * 32 + row) * 1024 + (MEM ? 768 : 0) + h * 64 + ch * 8) = v; }
    asm volatile("s_waitcnt vmcnt(0) lgkmcnt(0)\n\ts_barrier" ::: "memory");
#undef ATT_DMA_K
#undef ATT_DMA_V
#undef ATT_DMA_M
#undef ATT_QK
}
}
__device__ __forceinline__ void attn_dense_phase(Frame& F, int layer) {
    int tid_ = F.wave * 64 + lane_id_now(); unsigned char* ws_ = F.ws; asm volatile("" : "+s"(ws_));
    const int lane = tid_ & 63;
    const float* gn_ = (const float*)(ws_ + WS_GN) + layer * 64 + lane;
    float gq = fabsf(gn_[0]), gk = fabsf(gn_[DEPTH * 64]), gmq = fabsf(gn_[2 * DEPTH * 64]), gmk = fabsf(gn_[3 * DEPTH * 64]);
#pragma unroll
    for (int o = 1; o < 64; o <<= 1) { gq = fmaxf(gq, __shfl_xor(gq, o)); gk = fmaxf(gk, __shfl_xor(gk, o)); gmq = fmaxf(gmq, __shfl_xor(gmq, o)); gmk = fmaxf(gmk, __shfl_xor(gmk, o)); }
    const float moffA = 64.0f * C2 * gq * gk, moffM = 64.0f * C2 * gmq * gmk;
    const int G = F.G, v = (G % 8 == 0) ? ((int)blockIdx.x % 8) * (G / 8) + (int)blockIdx.x / 8 : (int)blockIdx.x;
    for (int i = 0;; ++i) {
        int bh, qb;
        if (G == 256) { if (i >= 4) break; const int c = v & 31; bh = (i >> 1) * 8 + (v >> 5); qb = (i & 1) ? 63 - c : c; }
        else { const int u = v + i * G; if (u >= 1024) break; bh = u & 15; qb = 63 - (u >> 4); }
        const int b = bh >> 3, h = bh & 7; const size_t rb = (size_t)b * SEQ;
        att::unit<false>(h, qb, (const bf16*)(ws_ + WS_AQ) + rb * 256, (const bf16*)(ws_ + WS_AK) + rb * 256, (const bf16*)(ws_ + WS_AV + (size_t)b * (8 * 64) * SEQ),
                         (const unsigned*)F.out + rb * 512, (bf16*)(ws_ + WS_CAT) + rb * 1024, F.lds, tid_, moffA);
    }
    for (int u = v; u < 512; u += G) { const int qb = u & 63, bh = u >> 6, b = bh >> 2, h = bh & 3; const size_t rb = (size_t)b * SEQ;
        att::unit<true>(h, qb, (const bf16*)(ws_ + WS_MQ) + rb * 256, (const bf16*)(ws_ + WS_MEMK) + (size_t)(layer * 2 + b) * 256 * 256, (const bf16*)(ws_ + WS_MEMV) + (size_t)(layer * 2 + b) * 256 * 256,
                        nullptr, (bf16*)(ws_ + WS_CAT) + rb * 1024, F.lds, tid_, moffM); }
}
namespace tk {
typedef float f32x16 __attribute__((ext_vector_type(16)));
constexpr int CAP = 1024;
constexpr int L_LIST = 0, L_CTL = 131072 + 1024, L_HIST = 131072 + 2048;
__device__ __forceinline__ unsigned sortable(float s) { unsigned u = __builtin_bit_cast(unsigned, s); if (u == 0x80000000u) u = 0u; return (u & 0x80000000u) ? ~u : (u | 0x80000000u); }
__device__ __forceinline__ float unsortable(unsigned u) { const unsigned b = (u & 0x80000000u) ? (u & 0x7fffffffu) : ~u; return __builtin_bit_cast(float, b); }
__device__ __forceinline__ int crow(int r, int hi) { return (r & 3) + 8 * (r >> 2) + 4 * hi; }
__device__ __forceinline__ int dpp_scan_add(int v) {
    v += __builtin_amdgcn_update_dpp(0, v, 0x111, 0xf, 0xf, true); v += __builtin_amdgcn_update_dpp(0, v, 0x112, 0xf, 0xf, true);
    v += __builtin_amdgcn_update_dpp(0, v, 0x114, 0xf, 0xf, true); v += __builtin_amdgcn_update_dpp(0, v, 0x118, 0xf, 0xf, true);
    v += __builtin_amdgcn_update_dpp(0, v, 0x142, 0xa, 0xf, false); v += __builtin_amdgcn_update_dpp(0, v, 0x143, 0xc, 0xf, false);
    return v;
}
__device__ __forceinline__ unsigned wave_or(unsigned v) {
    v |= (unsigned)__builtin_amdgcn_update_dpp(0, (int)v, 0x111, 0xf, 0xf, true); v |= (unsigned)__builtin_amdgcn_update_dpp(0, (int)v, 0x112, 0xf, 0xf, true);
    v |= (unsigned)__builtin_amdgcn_update_dpp(0, (int)v, 0x114, 0xf, 0xf, true); v |= (unsigned)__builtin_amdgcn_update_dpp(0, (int)v, 0x118, 0xf, 0xf, true);
    v |= (unsigned)__builtin_amdgcn_update_dpp(0, (int)v, 0x142, 0xa, 0xf, false); v |= (unsigned)__builtin_amdgcn_update_dpp(0, (int)v, 0x143, 0xc, 0xf, false);
    return (unsigned)__builtin_amdgcn_readlane((int)v, 63);
}
__device__ __forceinline__ unsigned select256(const unsigned (&e)[16], int n, int lane, LAS unsigned* hist, bool approx, int need0) {
    if (n <= need0) return 1u;
    unsigned xo = 0u, xn = 0u;
#pragma unroll
    for (int i = 0; i < 16; ++i) if (e[i] != 0u) { xo |= e[i]; xn |= ~e[i]; }
    xo = wave_or(xo); const unsigned xa = ~wave_or(xn);
    const unsigned diff = xo ^ xa;
    int pshift = 32 - __builtin_clz(diff | 1u);
    unsigned pval = (pshift >= 32) ? 0u : (xa >> pshift);
    int need = need0;
    while (pshift > 0) {
        const int shift = pshift > 8 ? pshift - 8 : 0, nbits = pshift - shift; const unsigned bmask = (1u << nbits) - 1u;
        *(LAS v4u*)(hist + 4 * lane) = (v4u){0u, 0u, 0u, 0u};
        asm volatile("s_waitcnt lgkmcnt(0)" ::: "memory");
#pragma unroll
        for (int i = 0; i < 16; ++i) { const bool in = (pshift >= 32) ? true : ((e[i] >> (pshift & 31)) == pval);
            const unsigned idx = in ? ((e[i] >> shift) & bmask) : (unsigned)(256 + lane);
            __hip_atomic_fetch_add(hist + idx, 1u, __ATOMIC_RELAXED, __HIP_MEMORY_SCOPE_WORKGROUP); }
        asm volatile("s_waitcnt lgkmcnt(0)" ::: "memory");
        const v4u c = *(LAS const v4u*)(hist + 4 * lane);
        const int ls = (int)(c[0] + c[1] + c[2] + c[3]);
        const int pre = dpp_scan_add(ls), tot = __builtin_amdgcn_readlane(pre, 63);
        const int incl = tot - pre + ls, above = incl - ls;
        const bool hit = (above < need) && (need <= incl);
        int bin = 0, nneed = 0, bcnt = 0;
        { int a = above;
            if (a + (int)c[3] >= need) { bin = 3; nneed = need - a; bcnt = (int)c[3]; } else { a += (int)c[3];
            if (a + (int)c[2] >= need) { bin = 2; nneed = need - a; bcnt = (int)c[2]; } else { a += (int)c[2];
            if (a + (int)c[1] >= need) { bin = 1; nneed = need - a; bcnt = (int)c[1]; } else { a += (int)c[1]; bin = 0; nneed = need - a; bcnt = (int)c[0]; } } }
            bin += 4 * lane; }
        const unsigned long long hm = __ballot(hit);
        const int src = __builtin_ctzll(hm | (1ull << 63));
        bin = __builtin_amdgcn_readlane(bin, src); nneed = __builtin_amdgcn_readlane(nneed, src); bcnt = __builtin_amdgcn_readlane(bcnt, src);
        pval = (pval << nbits) | (unsigned)bin; pshift = shift; need = nneed;
        if (bcnt == need || (approx && need0 - need + bcnt <= need0 + (need0 >> 1))) break;
    }
    const unsigned tc_ = pshift >= 32 ? 0u : (pval << pshift);
    return tc_ == 0u ? 1u : tc_;
}
}
__device__ __forceinline__ void topk_fast_phase(Frame& F, int layer) {
    int tid_ = F.wave * 64 + lane_id_now(); unsigned char* ws_ = F.ws; asm volatile("" : "+s"(ws_));
    const int tid = tid_, lane = tid & 63, r32 = lane & 31, hi = lane >> 5, wid = __builtin_amdgcn_readfirstlane(tid >> 6);
    const GAS bf16* IQ = (const GAS bf16*)(ws_ + WS_IQ); const GAS bf16* IK = (const GAS bf16*)(ws_ + WS_IK); const GAS float* IW = (const GAS float*)(ws_ + WS_IW);
    GAS unsigned* BM = (GAS unsigned*)F.out;
    LAS unsigned* list = (LAS unsigned*)(F.lds + tk::L_LIST);
    LAS unsigned* cnt = (LAS unsigned*)(F.lds + tk::L_CTL); LAS float* tau = (LAS float*)(F.lds + tk::L_CTL + 128); LAS unsigned* flag = (LAS unsigned*)(F.lds + tk::L_CTL + 256);
    LAS unsigned* hist = (LAS unsigned*)(F.lds + tk::L_HIST) + wid * 320;
    const int G = F.G;
    (void)G;
    GAS unsigned* queue = (GAS unsigned*)(ws_ + WS_TKQ) + layer * 16;
    LAS unsigned* tick = flag + 8;
    LAS unsigned* tcm = (LAS unsigned*)(F.lds + tk::L_CTL + 384);
    if (tid == 0) tick[0] = __hip_atomic_fetch_add(queue, 1u, __ATOMIC_RELAXED, __HIP_MEMORY_SCOPE_AGENT);
    __syncthreads();
#pragma unroll 1
      for (;;) {
        const unsigned un = tick[0];
        if (un >= 1024u) break;
        unsigned nxt = 0u; if (tid == 0) nxt = __hip_atomic_fetch_add(queue, 1u, __ATOMIC_RELAXED, __HIP_MEMORY_SCOPE_AGENT);
        const int b = (int)(un & 1u), j = 511 - (int)(un >> 1), t0 = 32 * j; const size_t rb = (size_t)b * SEQ;
        bf16x8 qf[4][4];
        { const GAS bf16* qp = IQ + (rb + t0 + r32) * 256 + hi * 8;
#pragma unroll
          for (int h = 0; h < 4; ++h)
#pragma unroll
            for (int d0 = 0; d0 < 4; ++d0) qf[h][d0] = *(const GAS bf16x8*)(qp + h * 64 + d0 * 16); }
        const f32x4 wv = *(const GAS f32x4*)(IW + (rb + t0 + r32) * 4);
        bool aggr = true;
#pragma unroll 1
      for (;;) {
        if (tid < 32) { cnt[tid] = 0u; tau[tid] = -INFINITY; tcm[tid] = 1u; }
        if (tid < 8) flag[tid] = 0u;
        __syncthreads();
        const int ntiles = j + 1;
        const GAS bf16* kp = IK + (rb + r32) * 64 + hi * 8;
        bf16x8 kf[4];
        const int KW = ntiles > wid ? (ntiles - wid + 7) >> 3 : 0, lg2 = KW > 1 ? 32 - __builtin_clz((unsigned)(KW - 1)) : 0, sEnd = KW > 0 ? (1 << lg2) : 0;
#define TK_BREV(s_) (lg2 ? (int)(((__builtin_bitreverse32((unsigned)(s_)) >> (32 - lg2)) + (((unsigned)wid << lg2) >> 3)) & (unsigned)(sEnd - 1)) : 0)
        int it = 0, nproc = 0; bool counted = false;
        while (it < sEnd && TK_BREV(it) >= KW) ++it;
        if (it < sEnd) { const int t1 = wid + 8 * TK_BREV(it);
#pragma unroll
            for (int d0 = 0; d0 < 4; ++d0) kf[d0] = *(const GAS bf16x8*)(kp + (size_t)(32 * t1) * 64 + d0 * 16); }
#pragma unroll 1
        for (;;) {
#pragma unroll 1
            while (it < sEnd) {
                if (__hip_atomic_load(flag, __ATOMIC_RELAXED, __HIP_MEMORY_SCOPE_WORKGROUP) != 0u) break;
                const int tile = wid + 8 * TK_BREV(it);
                int itn = it + 1; while (itn < sEnd && TK_BREV(itn) >= KW) ++itn;
                float s[16];
#pragma unroll
                for (int h = 0; h < 4; ++h) { tk::f32x16 acc;
#pragma unroll
                    for (int r = 0; r < 16; ++r) acc[r] = 0.f;
#pragma unroll
                    for (int d0 = 0; d0 < 4; ++d0) acc = __builtin_amdgcn_mfma_f32_32x32x16_bf16(kf[d0], qf[h][d0], acc, 0, 0, 0);
#pragma unroll
                    for (int r = 0; r < 16; ++r) { const float af = acc[r]; const int ai = __builtin_bit_cast(int, af); const float rl = __builtin_bit_cast(float, ai > 0 ? ai : 0);
                        if (h == 0) asm volatile("v_fma_f32 %0, %1, %2, 0" : "=v"(s[r]) : "v"(wv[0]), "v"(rl));
                        else asm volatile("v_fma_f32 %0, %1, %2, %0" : "+v"(s[r]) : "v"(wv[h]), "v"(rl)); } }
                if (itn < sEnd) { const int tnx = wid + 8 * TK_BREV(itn);
#pragma unroll
                    for (int d0 = 0; d0 < 4; ++d0) kf[d0] = *(const GAS bf16x8*)(kp + (size_t)(32 * tnx) * 64 + d0 * 16); }
                const float tq = tau[r32];
                if (tile == j) { int rl = r32, hl = hi; asm volatile("" : "+v"(rl), "+v"(hl));
#pragma unroll
                    for (int r = 0; r < 16; ++r) if (tk::crow(r, hl) > rl) s[r] = __builtin_nanf(""); }
                unsigned long long pm[16]; int np = 0;
#pragma unroll
                for (int r = 0; r < 16; ++r) { pm[r] = __ballot(s[r] >= tq); np += __builtin_amdgcn_inverse_ballot_w64(pm[r]) ? 1 : 0; }
                bool over = false;
                if (__any(np > 0)) {
                    unsigned pos = 0u;
                    if (np > 0) { pos = __hip_atomic_fetch_add(cnt + r32, (unsigned)np, __ATOMIC_RELAXED, __HIP_MEMORY_SCOPE_WORKGROUP); over = pos + (unsigned)np > 768u; }
                    const unsigned lpa = (unsigned)(uintptr_t)(list + r32 * tk::CAP);
                    const unsigned bb = 0xffffc000u | (unsigned)(0x3fe0 - 32 * tile) | (hi ? 0u : 4u);
#pragma unroll
                    for (int r = 0; r < 16; ++r) { const bool pass = __builtin_amdgcn_inverse_ballot_w64(pm[r]);
                        const unsigned ub = __builtin_bit_cast(unsigned, s[r]); const unsigned su = ub ^ ((unsigned)((int)ub >> 31) | 0x80000000u);
                        const unsigned cr = 0xffffc000u | (unsigned)(8 * (3 - (r >> 2)) + 3 - (r & 3)); const unsigned bc = bb & cr;
                        const unsigned comp = (su & bc) | ((bb | cr) & ~bc);
                        const unsigned addr = lpa + ((pos ^ (unsigned)r32) << 2);
                        unsigned long long keep;
                        asm volatile("s_mov_b64 %0, exec\n\ts_mov_b64 exec, %1\n\tds_write_b32 %2, %3\n\ts_mov_b64 exec, %0" : "=&s"(keep) : "s"(pm[r]), "v"(addr), "v"(comp) : "memory");
                        pos += pass ? 1u : 0u; }
                }
                it = itn; ++nproc;
                if (__any(over)) { if (lane == 0) __hip_atomic_store(flag, 1u, __ATOMIC_RELAXED, __HIP_MEMORY_SCOPE_WORKGROUP); break; }
            }
            if (it >= sEnd && !counted) { counted = true; if (lane == 0) __hip_atomic_fetch_add(flag + 1, 1u, __ATOMIC_RELAXED, __HIP_MEMORY_SCOPE_WORKGROUP); }
            if (lane == 0) __hip_atomic_fetch_add(flag + 3, (unsigned)nproc, __ATOMIC_RELAXED, __HIP_MEMORY_SCOPE_WORKGROUP);
            asm volatile("s_waitcnt lgkmcnt(0)" ::: "memory");
            __syncthreads();
            const unsigned fcut = flag[0], ndone = flag[1];
            int rk = NSEL;
            if (aggr) { const int pd = __builtin_amdgcn_readfirstlane((int)flag[3]); const float f = fminf(1.0f, (float)pd / (float)ntiles);
                rk = (int)(256.0f * f + 5.0f * __builtin_sqrtf(256.0f * f * (1.0f - f)) + 8.0f); rk = rk > NSEL ? NSEL : rk; }
            if (fcut != 0u) {
#pragma unroll 1
                for (int qi = 0; qi < 4; ++qi) { const int q = 4 * wid + qi; const int n = (int)cnt[q]; LAS unsigned* lp = list + q * tk::CAP;
                    if (n > rk) {
                        int ln = lane; asm volatile("" : "+v"(ln));
                        unsigned e[16];
                        { LAS const unsigned* lq = lp + (ln ^ q);
#pragma unroll
                        for (int i = 0; i < 16; ++i) { const unsigned x = lq[i * 64]; e[i] = (i * 64 + ln < n) ? x : 0u; } }
                        const unsigned tc = tk::select256(e, n, ln, hist, true, rk);
                        int kc = 0;
#pragma unroll
                        for (int i = 0; i < 16; ++i) kc += (e[i] >= tc) ? 1 : 0;
                        const int incl_ = tk::dpp_scan_add(kc); int pos = incl_ - kc; const int kept = __builtin_amdgcn_readlane(incl_, 63);
                        asm volatile("s_waitcnt lgkmcnt(0)" ::: "memory");
#pragma unroll
                        for (int i = 0; i < 16; ++i) if (e[i] >= tc) { lp[pos ^ q] = e[i]; ++pos; }
                        if (ln == 0) { cnt[q] = (unsigned)kept; tau[q] = tk::unsortable(tc & 0xffffc000u); if (tc > tcm[q]) tcm[q] = tc; }
                    }
                }
                __syncthreads();
                if (tid == 0) { flag[0] = 0u; flag[3] = 0u; }
                __syncthreads();
            } else if (ndone == (unsigned)NWAVES) break;
            else { __syncthreads(); if (tid == 0) flag[3] = 0u; __syncthreads(); }
        }
#pragma unroll 1
        for (int qi = 0; qi < 4; ++qi) { const int q = 4 * wid + qi; const int n = (int)cnt[q]; LAS unsigned* lp = list + q * tk::CAP;
            unsigned e[16];
            { LAS const unsigned* lq = lp + (lane ^ q);
#pragma unroll
            for (int i = 0; i < 16; ++i) { const unsigned x = lq[i * 64]; e[i] = (i * 64 + lane < n) ? x : 0u; } }
            if (aggr) {
                const unsigned tm = tcm[q]; int kcv = 0;
#pragma unroll
                for (int i = 0; i < 16; ++i) kcv += (e[i] >= tm) ? 1 : 0;
                const int tot = __builtin_amdgcn_readlane(tk::dpp_scan_add(kcv), 63);
                if (lane == 0 && tot < (t0 + q + 1 < NSEL ? t0 + q + 1 : NSEL)) flag[5] = 1u; }
            const unsigned tc = tk::select256(e, n, lane, hist, false, NSEL);
            asm volatile("s_waitcnt lgkmcnt(0)" ::: "memory");
#pragma unroll
            for (int i = 0; i < 8; ++i) lp[i * 64 + lane] = 0u;
            asm volatile("s_waitcnt lgkmcnt(0)" ::: "memory");
#pragma unroll
            for (int i = 0; i < 16; ++i) if (e[i] >= tc) { const unsigned idx = 0x3fffu - (e[i] & 0x3fffu);
                __hip_atomic_fetch_or(lp + (idx >> 5), 1u << (idx & 31u), __ATOMIC_RELAXED, __HIP_MEMORY_SCOPE_WORKGROUP); }
            asm volatile("s_waitcnt lgkmcnt(0)" ::: "memory");
            GAS unsigned* row = BM + (rb + t0 + q) * 512;
#pragma unroll
            for (int i = 0; i < 8; ++i) row[i * 64 + lane] = lp[i * 64 + lane];
        }
        __syncthreads();
        const unsigned bad = flag[5];
        __syncthreads();
        if (!(aggr && bad != 0u)) break;
        aggr = false;
      }
        if (tid == 0) tick[0] = nxt;
        __syncthreads();
      }
}
__global__ void __launch_bounds__(NWAVES * 64, 2) fwd_kernel(Args args) {
    extern __shared__ __attribute__((aligned(16))) unsigned char lds[];
    Frame F;
    F.lds = (LAS unsigned char*)lds;
    F.MISC = (volatile LAS unsigned*)(F.lds + MISC_OFF);
    F.tid = threadIdx.x; F.lane = F.tid & 63; F.wave = __builtin_amdgcn_readfirstlane(F.tid >> 6);
    F.G = gridDim.x; F.ws = args.ws; F.out = args.out;
    F.ctl = (gu32*)(F.ws + WS_CTL);
    for (int u = F.tid; u < (LDS_BYTES - LDSCTL_OFF) / 4; u += NWAVES * 64) ((LAS unsigned*)(F.lds + LDSCTL_OFF))[u] = 0u;
    __syncthreads();
    XcdBarrier bar = xcd_barrier_post((unsigned*)(F.ctl + CW_BAR), F.MISC + 8, F.tid);
#define PHASE_TID() (F.wave * 64 + lane_id_now())
#define GRID_BAR() xcd_barrier(bar, PHASE_TID())
    LAS unsigned char* ring = F.lds + RING_OFF;
#define PHASE_WS() unsigned char* wsp = F.ws; asm volatile("" : "+s"(wsp))

    p0_prologue(F, args);
    GRID_BAR();
    const int kvwg = (F.G >= 64) ? 16 : 0;
    p0b_quant(F, args, kvwg);
    {
        PHASE_WS();
        pg8::Gemm g{(const bf16*)(wsp + WS_MEMB), (const bf16*)(wsp + WS_WKV), 512, DEPTH * 512, DM}; pg8::StaticOrder S; S.init(512, DEPTH * 512, F.G, (int)blockIdx.x);
        pg8::EpiMix<1> E{(const float*)(wsp + WS_SSM), (bf16*)(wsp + WS_MEMK), nullptr, (bf16*)(wsp + WS_MEMV), nullptr, nullptr, nullptr, nullptr, nullptr, nullptr, (const float*)(wsp + WS_GN) + 3 * DEPTH * 64, nullptr, 1.0f};
        pg8::gemm_phase<pg8::EpiMix<1>, pg8::StaticOrder, true, true>(ring, g, S, E, PHASE_TID());
    }
    GRID_BAR();
    for (int l = 0; l < DEPTH; ++l) {
        {
            PHASE_WS(); unsigned char* wl = wsp + WS_W + (size_t)l * WL_STRIDE;
            pg8::Gemm g{(const bf16*)(wsp + WS_XQ), (const bf16*)(wl + WL_1GU), T, NGU, DM / 2}; pg8::StaticOrder S; S.init(T, NGU, F.G, (int)blockIdx.x);
            pg8::EpiGLU8 E{(bf16*)(wsp + WS_ACT), (const float*)(wsp + WS_SSP), (const float*)(wsp + WS_SX), (const float*)(wsp + WS_SW) + ((size_t)l * 2 + 0) * NGU, DFF};
            pg8::gemm_phase<pg8::EpiGLU8, pg8::StaticOrder, true, true, 1>(ring, g, S, E, PHASE_TID());
        }
        GRID_BAR();
        {
            PHASE_WS(); unsigned char* wl = wsp + WS_W + (size_t)l * WL_STRIDE;
            pg8::Gemm g{(const bf16*)(wsp + WS_ACT), (const bf16*)(wl + WL_1D), T, DM, DFF / 2}; pg8::StaticOrder S; S.init(T, DM, F.G, (int)blockIdx.x);
            pg8::EpiResT<true> E{nullptr, (bf16*)(wsp + WS_XB), (pg8::u64_t*)(wsp + WS_SSP) + (size_t)(3 * l + 1) * T, 0.5f / pg8::H8_SCALE, (const float*)(wsp + WS_SWD) + (size_t)(2 * l) * DM};
            pg8::gemm_phase<pg8::EpiResT<true>, pg8::StaticOrder, true, true, 2>(ring, g, S, E, PHASE_TID());
        }
        GRID_BAR();
        {
            PHASE_WS(); unsigned char* wl = wsp + WS_W + (size_t)l * WL_STRIDE;
            pg8::Gemm g{(const bf16*)(wsp + WS_XB), (const bf16*)(wl + WL_IN), T, NIN, DM}; pg8::StaticOrder S; S.init(T, NIN, F.G, (int)blockIdx.x);
            pg8::EpiMix<0> E{(const pg8::u64_t*)(wsp + WS_SSP) + (size_t)(3 * l + 1) * T, (bf16*)(wsp + WS_AQ), (bf16*)(wsp + WS_AK), (bf16*)(wsp + WS_AV), (bf16*)(wsp + WS_IQ), (bf16*)(wsp + WS_PU), (bf16*)(wsp + WS_MQ), (bf16*)(wsp + WS_IK), (float*)(wsp + WS_IW),
                             (const float*)(wsp + WS_GN) + l * 64, (const float*)(wsp + WS_GN) + (DEPTH + l) * 64, (const float*)(wsp + WS_GN) + (2 * DEPTH + l) * 64, C2};
            pg8::gemm_phase<pg8::EpiMix<0>, pg8::StaticOrder, true, true>(ring, g, S, E, PHASE_TID());
        }
        GRID_BAR();
        topk_fast_phase(F, l);
        GRID_BAR();
        attn_dense_phase(F, l);
        pool_phase(F);
        GRID_BAR();
        {
            PHASE_WS(); unsigned char* wl = wsp + WS_W + (size_t)l * WL_STRIDE;
            pg8::Gemm g{(const bf16*)(wsp + WS_CAT), (const bf16*)(wl + WL_OUT), T, DM, DM}; pg8::StaticOrder S; S.init(T, DM, F.G, (int)blockIdx.x);
            pg8::EpiResT<false> E{nullptr, (bf16*)(wsp + WS_XB), (pg8::u64_t*)(wsp + WS_SSP) + (size_t)(3 * l + 2) * T, 1.0f, nullptr};
            pg8::gemm_phase<pg8::EpiResT<false>, pg8::StaticOrder, true, true>(ring, g, S, E, PHASE_TID());
        }
        GRID_BAR();
        xquant_phase(F, 3 * l + 2);
        GRID_BAR();
        {
            PHASE_WS(); unsigned char* wl = wsp + WS_W + (size_t)l * WL_STRIDE;
            pg8::Gemm g{(const bf16*)(wsp + WS_XQ), (const bf16*)(wl + WL_2GU), T, NGU, DM / 2}; pg8::StaticOrder S; S.init(T, NGU, F.G, (int)blockIdx.x);
            pg8::EpiGLU8 E{(bf16*)(wsp + WS_ACT), (const float*)(wsp + WS_SSP), (const float*)(wsp + WS_SX), (const float*)(wsp + WS_SW) + ((size_t)l * 2 + 1) * NGU, DFF};
            pg8::gemm_phase<pg8::EpiGLU8, pg8::StaticOrder, true, true, 1>(ring, g, S, E, PHASE_TID());
        }
        GRID_BAR();
        {
            PHASE_WS(); unsigned char* wl = wsp + WS_W + (size_t)l * WL_STRIDE;
            pg8::Gemm g{(const bf16*)(wsp + WS_ACT), (const bf16*)(wl + WL_2D), T, DM, DFF / 2}; pg8::StaticOrder S; S.init(T, DM, F.G, (int)blockIdx.x);
            pg8::EpiResT<true> E{(l == DEPTH - 1) ? F.out : nullptr, (bf16*)(wsp + WS_XB), (pg8::u64_t*)(wsp + WS_SSP) + (size_t)(3 * l + 3) * T, 0.5f / pg8::H8_SCALE, (const float*)(wsp + WS_SWD) + (size_t)(2 * l + 1) * DM};
            pg8::gemm_phase<pg8::EpiResT<true>, pg8::StaticOrder, true, true, 2>(ring, g, S, E, PHASE_TID());
        }
        if (l + 1 < DEPTH) { GRID_BAR(); xquant_phase(F, 3 * l + 3); GRID_BAR(); }
    }
}

extern "C" void kernel_launch(void* const* d_in, const int* in_sizes, int n_in, void* d_out, int out_size, void* d_ws, size_t ws_size, hipStream_t stream) {
    static int grid = 0;
    if (grid == 0) {
        if (n_in != 21 || out_size != T * DM || ws_size < WS_END) { fprintf(stderr, "kernel_launch: unexpected shapes (n_in %d, out %d, ws %zu)\n", n_in, out_size, ws_size); grid = -1; return; }
        int dev = 0, cus = 0, per_cu = 0;
        if (hipGetDevice(&dev) != hipSuccess || hipDeviceGetAttribute(&cus, hipDeviceAttributeMultiprocessorCount, dev) != hipSuccess) { grid = -1; return; }
        if (hipFuncSetAttribute((const void*)fwd_kernel, hipFuncAttributeMaxDynamicSharedMemorySize, LDS_BYTES) != hipSuccess) { fprintf(stderr, "kernel_launch: hipFuncSetAttribute failed\n"); grid = -1; return; }
        if (hipOccupancyMaxActiveBlocksPerMultiprocessor(&per_cu, (const void*)fwd_kernel, NWAVES * 64, LDS_BYTES) != hipSuccess || per_cu < 1) { fprintf(stderr, "kernel_launch: occupancy query says %d\n", per_cu); }
        (void)hipGetLastError();
        grid = cus;
    }
    if (grid < 0) return;
    if (hipMemsetAsync((char*)d_ws + WS_CTL, 0, CTL_ZERO_BYTES, stream) != hipSuccess) return;
    Args a{};
    for (int i = 0; i < 21; ++i) a.in[i] = (const float*)d_in[i];
    a.out = (float*)d_out; a.ws = (unsigned char*)d_ws;
    hipLaunchKernelGGL(fwd_kernel, dim3(grid), dim3(NWAVES * 64), LDS_BYTES, stream, a);
}
```
